# Optimizing an MI355X kernel written in HIP

```python
import math
import jax, jax.numpy as jnp
from jax import lax
import numpy as np

D_MODEL = 4096
BATCH = 1
SEQ = 8192
DEPTH = 1

MIX_WIDTH = D_MODEL
MOBA_HEADS = 16
MOBA_HEAD_DIM = (MIX_WIDTH // 2) // MOBA_HEADS
MOBA_WIDTH = MOBA_HEADS * MOBA_HEAD_DIM
MOBA_BLOCK = 256
MOBA_TOPK = 3
MOBA_Q_CHUNK = 32
RET_HEADS = 8
RET_HEAD_DIM = (MIX_WIDTH - MOBA_WIDTH) // RET_HEADS
RET_WIDTH = RET_HEADS * RET_HEAD_DIM
RET_CHUNK = 512
ROPE_BASE = 10000.0
REL_BUCKETS = 32
REL_MAX_DIST = 128
IN_WIDTH = 3 * MOBA_WIDTH + 4 * RET_WIDTH
PEER_HEADS = 8
PEER_NKEYS = 128
PEER_EXPERTS = PEER_NKEYS * PEER_NKEYS
PEER_QDIM = 256
PEER_TOPK = 16
PEER_T_CHUNK = 64
NORM_EPS = 1e-6
GN_EPS = 1e-6
NEG = -1e30

kernel_name = 'hymba_moba_retnet_peer_layer'


def rmsnorm(x, g):
    xf = x.astype(jnp.float32)
    y = xf * lax.rsqrt(jnp.mean(xf * xf, axis=-1, keepdims=True) + NORM_EPS) * g.astype(jnp.float32)
    return y.astype(x.dtype)


def t5_bucket(n):
    n = jnp.maximum(n, 0)
    max_exact = REL_BUCKETS // 2
    nf = jnp.maximum(n, 1).astype(jnp.float32)
    large = max_exact + (jnp.log(nf / max_exact) / math.log(REL_MAX_DIST / max_exact)
                         * (REL_BUCKETS - max_exact)).astype(jnp.int32)
    large = jnp.minimum(large, REL_BUCKETS - 1)
    return jnp.where(n < max_exact, n, large)


def rotary(x, pos):
    half = x.shape[-1] // 2
    inv = ROPE_BASE ** (-jnp.arange(half, dtype=jnp.float32) / half)
    ang = pos.astype(jnp.float32)[:, None] * inv[None, :]
    cos = jnp.cos(ang)[None, :, None, :]
    sin = jnp.sin(ang)[None, :, None, :]
    xf = x.astype(jnp.float32)
    x1, x2 = xf[..., :half], xf[..., half:]
    return jnp.concatenate([x1 * cos - x2 * sin, x1 * sin + x2 * cos], axis=-1).astype(x.dtype)


def moba_attention(q, k, v, rel_bias):
    B, S, H, Dh = q.shape
    nblk = -(-S // MOBA_BLOCK)
    n_sel = min(MOBA_TOPK, nblk)
    Lp = nblk * MOBA_BLOCK
    pad = ((0, 0), (0, Lp - S), (0, 0), (0, 0))
    q, k, v = jnp.pad(q, pad), jnp.pad(k, pad), jnp.pad(v, pad)
    kb = k.reshape(B, nblk, MOBA_BLOCK, H, Dh)
    vb = v.reshape(B, nblk, MOBA_BLOCK, H, Dh)
    kmean = jnp.mean(kb.astype(jnp.float32), axis=2)
    kbh = kb.transpose(0, 3, 1, 2, 4)
    vbh = vb.transpose(0, 3, 1, 2, 4)
    scale = Dh ** -0.5
    n_chunks = Lp // MOBA_Q_CHUNK
    qc = q.reshape(B, n_chunks, MOBA_Q_CHUNK, H, Dh).transpose(1, 0, 2, 3, 4)
    blk_ids = jnp.arange(nblk)
    offs = jnp.arange(MOBA_BLOCK)
    bidx = jnp.arange(B)[:, None, None, None]
    hidx = jnp.arange(H)[None, None, :, None]

    def one_chunk(args):
        qi, ci = args
        start = ci * MOBA_Q_CHUNK
        cur = start // MOBA_BLOCK
        qpos = start + jnp.arange(MOBA_Q_CHUNK)
        qf = qi.astype(jnp.float32)
        gate = jnp.einsum('bqhd,bnhd->bqhn', qf, kmean)
        gate = jnp.where(blk_ids < cur, gate, NEG)
        _, sel = lax.top_k(gate, n_sel)
        sel_valid = sel < cur
        k_sel = kbh[bidx, hidx, sel]
        v_sel = vbh[bidx, hidx, sel]
        s_sel = jnp.einsum('bqhd,bqhjkd->bqhjk', qf * scale, k_sel.astype(jnp.float32))
        rel_sel = qpos[None, :, None, None, None] - (sel[..., None] * MOBA_BLOCK + offs)
        s_sel = s_sel + rel_bias[t5_bucket(rel_sel), hidx[..., None]].astype(jnp.float32)
        s_sel = jnp.where(sel_valid[..., None], s_sel, NEG)
        s_sel = s_sel.reshape(B, MOBA_Q_CHUNK, H, n_sel * MOBA_BLOCK)
        k_own = lax.dynamic_index_in_dim(kbh, cur, axis=2, keepdims=False)
        v_own = lax.dynamic_index_in_dim(vbh, cur, axis=2, keepdims=False)
        s_own = jnp.einsum('bqhd,bhkd->bqhk', qf * scale, k_own.astype(jnp.float32))
        rel_own = qpos[:, None] - (cur * MOBA_BLOCK + offs)[None, :]
        s_own = s_own + rel_bias[t5_bucket(rel_own)].transpose(0, 2, 1)[None].astype(jnp.float32)
        s_own = jnp.where((rel_own >= 0)[None, :, None, :], s_own, NEG)
        p = jax.nn.softmax(jnp.concatenate([s_sel, s_own], axis=-1), axis=-1)
        p_sel = p[..., :n_sel * MOBA_BLOCK].reshape(B, MOBA_Q_CHUNK, H, n_sel, MOBA_BLOCK)
        p_own = p[..., n_sel * MOBA_BLOCK:]
        out = (jnp.einsum('bqhjk,bqhjkd->bqhd', p_sel, v_sel.astype(jnp.float32))
               + jnp.einsum('bqhk,bhkd->bqhd', p_own, v_own.astype(jnp.float32)))
        return out.astype(q.dtype)

    out = lax.map(one_chunk, (qc, jnp.arange(n_chunks)))
    return out.transpose(1, 0, 2, 3, 4).reshape(B, Lp, H, Dh)[:, :S]


def retention(q, k, v):
    B, S, H, D = q.shape
    C = RET_CHUNK
    n = -(-S // C)
    Lp = n * C
    pad = ((0, 0), (0, Lp - S), (0, 0), (0, 0))
    q, k, v = (jnp.pad(t.astype(jnp.float32), pad) for t in (q, k, v))
    log_g = jnp.log1p(-(2.0 ** (-5.0 - jnp.arange(H, dtype=jnp.float32))))
    idx = jnp.arange(C, dtype=jnp.float32)
    diff = idx[:, None] - idx[None, :]
    decay_intra = jnp.where(diff >= 0, jnp.exp(log_g[:, None, None] * jnp.maximum(diff, 0.0)), 0.0)
    q_decay = jnp.exp(log_g[:, None] * (idx + 1.0))[None, :, :, None]
    k_decay = jnp.exp(log_g[:, None] * (C - 1.0 - idx))[None, :, :, None]
    chunk_decay = jnp.exp(log_g * C)[None, :, None, None]
    to_chunks = lambda t: t.reshape(B, n, C, H, D).transpose(1, 0, 3, 2, 4)

    def step(state, inp):
        qc, kc, vc = inp
        inner = jnp.einsum('bhid,bhjd->bhij', qc, kc) * decay_intra[None]
        o = (jnp.einsum('bhij,bhjd->bhid', inner, vc)
             + jnp.einsum('bhid,bhde->bhie', qc * q_decay, state))
        state = state * chunk_decay + jnp.einsum('bhjd,bhje->bhde', kc * k_decay, vc)
        return state, o

    state0 = jnp.zeros((B, H, D, D), jnp.float32)
    _, o = lax.scan(step, state0, (to_chunks(q), to_chunks(k), to_chunks(v)))
    return o.transpose(1, 0, 3, 2, 4).reshape(B, Lp, H, D)[:, :S]


def head_group_norm(o):
    mu = jnp.mean(o, axis=-1, keepdims=True)
    var = jnp.mean(jnp.square(o - mu), axis=-1, keepdims=True)
    return (o - mu) * lax.rsqrt(var + GN_EPS)


def peer_ffn(xn, w_q, sub_keys, u, v):
    B, S, Dm = xn.shape
    T = B * S
    tok = xn.reshape(T, Dm)
    q = (tok @ w_q).astype(jnp.float32).reshape(T, PEER_HEADS, 2, PEER_QDIM // 2)
    s = jnp.einsum('thcd,hcnd->thcn', q, sub_keys.astype(jnp.float32))
    sv, si = lax.top_k(s, PEER_TOPK)
    cand_s = (sv[..., 0, :, None] + sv[..., 1, None, :]).reshape(T, PEER_HEADS, PEER_TOPK * PEER_TOPK)
    cand_e = (si[..., 0, :, None] * PEER_NKEYS + si[..., 1, None, :]).reshape(T, PEER_HEADS, PEER_TOPK * PEER_TOPK)
    top_s, top_pos = lax.top_k(cand_s, PEER_TOPK)
    experts = jnp.take_along_axis(cand_e, top_pos, axis=-1)
    gates = jax.nn.softmax(top_s, axis=-1)
    n_chunks = -(-T // PEER_T_CHUNK)
    Tp = n_chunks * PEER_T_CHUNK
    tok_p = jnp.pad(tok, ((0, Tp - T), (0, 0))).reshape(n_chunks, PEER_T_CHUNK, Dm)
    exp_p = jnp.pad(experts, ((0, Tp - T), (0, 0), (0, 0))).reshape(n_chunks, PEER_T_CHUNK, PEER_HEADS, PEER_TOPK)
    gate_p = jnp.pad(gates, ((0, Tp - T), (0, 0), (0, 0))).reshape(n_chunks, PEER_T_CHUNK, PEER_HEADS, PEER_TOPK)

    def one_chunk(args):
        tc, ec, gc = args
        u_sel = u[ec]
        act = jax.nn.gelu(jnp.einsum('td,thkd->thk', tc, u_sel).astype(jnp.float32), approximate=False)
        w = (act * gc).astype(v.dtype)
        return jnp.einsum('thk,thkd->td', w, v[ec])

    out = lax.map(one_chunk, (tok_p, exp_p, gate_p))
    return out.reshape(Tp, Dm)[:T].reshape(B, S, Dm).astype(xn.dtype)


def setup_inputs(seed: int = 0) -> dict:
    key = jax.random.key(seed)
    ks = jax.random.split(key, 12)
    f32 = jnp.float32
    x = jax.random.normal(ks[0], (BATCH, SEQ, D_MODEL), f32)
    norm_mix_g = 1.0 + 0.02 * jax.random.normal(ks[1], (DEPTH, D_MODEL), f32)
    w_in = jax.random.normal(ks[2], (DEPTH, D_MODEL, IN_WIDTH), f32) * D_MODEL ** -0.5
    w_out = jax.random.normal(ks[3], (DEPTH, MIX_WIDTH, D_MODEL), f32) * MIX_WIDTH ** -0.5
    rel_bias = 0.5 * jax.random.normal(ks[4], (REL_BUCKETS, MOBA_HEADS), f32)
    norm_ffn_g = 1.0 + 0.02 * jax.random.normal(ks[5], (DEPTH, D_MODEL), f32)
    peer_w_q = jax.random.normal(ks[6], (DEPTH, D_MODEL, PEER_HEADS * PEER_QDIM), f32) * D_MODEL ** -0.5
    peer_sub_keys = jax.random.normal(ks[7], (DEPTH, PEER_HEADS, 2, PEER_NKEYS, PEER_QDIM // 2), f32) * (PEER_QDIM // 2) ** -0.5
    peer_u = jax.random.normal(ks[8], (DEPTH, PEER_EXPERTS, D_MODEL), f32) * D_MODEL ** -0.5
    peer_v = jax.random.normal(ks[9], (DEPTH, PEER_EXPERTS, D_MODEL), f32) * PEER_HEADS ** -0.5
    norm_final_g = 1.0 + 0.02 * jax.random.normal(ks[10], (D_MODEL,), f32)
    return {'x': x, 'norm_mix_g': norm_mix_g, 'w_in': w_in, 'w_out': w_out, 'rel_bias': rel_bias,
            'norm_ffn_g': norm_ffn_g, 'peer_w_q': peer_w_q, 'peer_sub_keys': peer_sub_keys,
            'peer_u': peer_u, 'peer_v': peer_v, 'norm_final_g': norm_final_g}


def reference(x, norm_mix_g, w_in, w_out, rel_bias, norm_ffn_g, peer_w_q, peer_sub_keys,
              peer_u, peer_v, norm_final_g):
    B, S, _ = x.shape
    pos = jnp.arange(S, dtype=jnp.int32)
    splits = [MOBA_WIDTH, 2 * MOBA_WIDTH, 3 * MOBA_WIDTH, 3 * MOBA_WIDTH + RET_WIDTH,
              3 * MOBA_WIDTH + 2 * RET_WIDTH, 3 * MOBA_WIDTH + 3 * RET_WIDTH]
    h = x
    for layer in range(DEPTH):
        n = rmsnorm(h, norm_mix_g[layer])
        proj = n @ w_in[layer]
        mq, mk, mv, rq, rk, rv, rg = jnp.split(proj, splits, axis=-1)
        mshape = (B, S, MOBA_HEADS, MOBA_HEAD_DIM)
        a_out = moba_attention(mq.reshape(mshape), mk.reshape(mshape), mv.reshape(mshape), rel_bias)
        rshape = (B, S, RET_HEADS, RET_HEAD_DIM)
        rq = rotary(rq.reshape(rshape), pos)
        rk = rotary(rk.reshape(rshape), pos) * (RET_HEAD_DIM ** -0.5)
        r_out = head_group_norm(retention(rq, rk, rv.reshape(rshape))).reshape(B, S, RET_WIDTH)
        r_out = jax.nn.silu(rg.astype(jnp.float32)) * r_out
        mix = jnp.concatenate([a_out.reshape(B, S, MOBA_WIDTH).astype(h.dtype), r_out.astype(h.dtype)], axis=-1)
        h = h + mix @ w_out[layer]
        h = h + peer_ffn(rmsnorm(h, norm_ffn_g[layer]), peer_w_q[layer], peer_sub_keys[layer],
                         peer_u[layer], peer_v[layer])
    return rmsnorm(h, norm_final_g)
```

```cpp
#include <hip/hip_runtime.h>
#include <cstdio>
#include <cstdint>

#ifndef MK_ONE_LAUNCH
#define MK_ONE_LAUNCH 1
#endif

namespace pg8 {
#define PG8_LAS __attribute__((address_space(3)))
typedef unsigned short bf16_t;
typedef short bf16x8 __attribute__((ext_vector_type(8)));
typedef float f32x4 __attribute__((ext_vector_type(4)));
typedef unsigned u32x4 __attribute__((ext_vector_type(4)));
constexpr int BM = 256, BK = 64, HALF = 128, HTB = HALF * BK * 2  , STAGE_BYTES = 8 * HTB, NXCD = 8, WGM = 8;

__host__ __device__ __forceinline__ int lds_byte(int r, int c) { const int st = (r >> 4) * 2 + (c >> 5), rr = r & 15, cc = c & 31, ob = rr * 64 + cc * 2; return st * 1024 + (ob ^ (((ob >> 9) & 1) << 5)); }
__host__ __device__ __forceinline__ void stage_rc(int b, int& R, int& C) { const int st = b / 1024, sb = b % 1024, swz = sb ^ (((sb >> 9) & 1) << 5); R = (st >> 1) * 16 + swz / 64; C = (st & 1) * 32 + (swz % 64) / 2; }
__host__ __device__ __forceinline__ int perm32(int rho) { const int n = rho >> 4, i = rho & 15; return 8 * (i >> 2) + 4 * n + (i & 3); }

typedef int v4i_t __attribute__((ext_vector_type(4)));
typedef int v8i_t __attribute__((ext_vector_type(8)));
typedef int v6i_t __attribute__((ext_vector_type(6)));
__device__ __forceinline__ v6i_t lo6(v8i_t v) { return __builtin_shufflevector(v, v, 0, 1, 2, 3, 4, 5); }
__device__ __forceinline__ v8i_t ld8(const PG8_LAS unsigned char* p) { const v4i_t a = *(const PG8_LAS v4i_t*)p, b = *(const PG8_LAS v4i_t*)(p + 1024); return __builtin_shufflevector(a, b, 0, 1, 2, 3, 4, 5, 6, 7); }
template <class...> struct pg8_void { typedef void type; };
template <class E, class = void> struct epi_state { struct type {}; static constexpr bool has = false; };
template <class E> struct epi_state<E, typename pg8_void<typename E::State>::type> { typedef typename E::State type; static constexpr bool has = true; };
struct Unit { int pm, pn, z; };
struct Gemm { const bf16_t* A; const bf16_t* Bt; int lda, ldb, K; long sAz, sBz; };

struct StaticOrder {
    int nM, nN, nwg, G, c;
    __host__ __device__ void init(int M, int N, int G_, int c_) { nM = M / BM; nN = N / BM; nwg = nM * nN; G = G_; c = c_; }
    __host__ __device__ bool next(int i, Unit& u) const {
        const long L = (long)i * G + c; if (L >= nwg) return false;
        int wgid = (int)L; { const int q = nwg / NXCD, r = nwg % NXCD, xcd = wgid % NXCD, off = wgid / NXCD; wgid = (xcd < r ? xcd * (q + 1) : r * (q + 1) + (xcd - r) * q) + off; }
        const int nig = WGM * nN, gid = wgid / nig, fm = gid * WGM, gsz = (nM - fm) < WGM ? (nM - fm) : WGM;
        u.pm = fm + ((wgid % nig) % gsz); u.pn = (wgid % nig) / gsz; u.z = 0; return true;
    }
    __device__ __forceinline__ void a_ready(const Unit&) const {}
    __device__ __forceinline__ void done(const Unit&) const {}
};

__device__ __forceinline__ unsigned cvt_pk_bf16(float lo, float hi) { unsigned r; asm volatile("v_cvt_pk_bf16_f32 %0, %1, %2" : "=v"(r) : "v"(lo), "v"(hi)); return r; }
typedef float f32x2 __attribute__((ext_vector_type(2)));
__device__ __forceinline__ f32x2 gelu_pk(f32x2 v) {
    const f32x2 av = __builtin_elementwise_abs(v), d = av * 0.2316418882f + 1.0f;
    f32x2 t; t.x = __builtin_amdgcn_rcpf(d.x); t.y = __builtin_amdgcn_rcpf(d.y);
    f32x2 q = t * 0.5307027145f + (-0.7265760135f); q = q * t + 0.7107068705f; q = q * t + (-0.142248368f); q = q * t + 0.127414796f; q = q * t;
    const f32x2 s = (v * v) * (-0.72134752044f);
    f32x2 e; e.x = __builtin_amdgcn_exp2f(s.x); e.y = __builtin_amdgcn_exp2f(s.y);
    const f32x2 m = v * (q * e), r = v - m;
    f32x2 o; o.x = v.x < 0.f ? m.x : r.x; o.y = v.y < 0.f ? m.y : r.y; return o;
}

template <int ACT  > struct EpiBf16 {
    static constexpr bool PERM = true, AFTER_DRAIN = false; static_assert(ACT == 0 || ACT == 1, "EpiBf16: ACT is 0 (none) or 1 (gelu_pk)");
    bf16_t* O; int ldc; const float* bias; int split_cols; size_t split_stride; float scale0, gs;
    __device__ __forceinline__ void operator()(const f32x4 (&acc)[2][2][4][2], const Unit& u, int wr, int wc, int fr, int fq) const {
        const int row0 = u.pm * BM + wr * 64 + fr; int colt = u.pn * BM; bf16_t* base = O;
        float sc = gs; if (split_cols) { const int t = colt / split_cols; base += (size_t)t * split_stride; colt -= t * split_cols; if (t == 0) sc = scale0 * gs; }
        const int col0 = colt + wc * 32 + 8 * fq, bcol0 = u.pn * BM + wc * 32 + 8 * fq;
        f32x4 bv[2][2];
#pragma unroll
        for (int bj = 0; bj < 2; ++bj)
#pragma unroll
            for (int n = 0; n < 2; ++n) bv[bj][n] = bias ? *(const f32x4*)(bias + bcol0 + bj * HALF + 4 * n) : (f32x4){0.f, 0.f, 0.f, 0.f};
#pragma unroll
        for (int ai = 0; ai < 2; ++ai)
#pragma unroll
            for (int m = 0; m < 4; ++m) { bf16_t* rowp = base + (size_t)(row0 + ai * HALF + m * 16) * ldc + col0;
#pragma unroll
                for (int bj = 0; bj < 2; ++bj) { f32x4 v0 = acc[ai][bj][m][0] + bv[bj][0], v1 = acc[ai][bj][m][1] + bv[bj][1];
                    if (ACT == 1) { f32x2 a = gelu_pk((f32x2){v0[0], v0[1]}), b = gelu_pk((f32x2){v0[2], v0[3]}), c = gelu_pk((f32x2){v1[0], v1[1]}), d = gelu_pk((f32x2){v1[2], v1[3]});
                        v0 = (f32x4){a.x, a.y, b.x, b.y}; v1 = (f32x4){c.x, c.y, d.x, d.y}; }
                    v0 = v0 * sc; v1 = v1 * sc; u32x4 w; w.x = cvt_pk_bf16(v0[0], v0[1]); w.y = cvt_pk_bf16(v0[2], v0[3]); w.z = cvt_pk_bf16(v1[0], v1[1]); w.w = cvt_pk_bf16(v1[2], v1[3]);
                    *(u32x4*)(rowp + bj * HALF) = w; } }
    }
};

template <class Epi, class Sched, bool ALIGN_EPI = false, bool SP2 = false, int F8 = 0>
__device__ __forceinline__ void gemm_phase(PG8_LAS unsigned char* lds, const Gemm g, const Sched& S, const Epi& E) {
    const int tid = threadIdx.x, wid = __builtin_amdgcn_readfirstlane(tid >> 6), lane = tid & 63, wr = wid >> 2, wc = wid & 3, fr = lane & 15, fq = lane >> 4;
    const int K = g.K, nt = K / BK;
    unsigned voffA[2], voffB[2];
#pragma unroll
    for (int i = 0; i < 2; ++i) { int R, C; stage_rc(tid * 16 + i * 8192, R, C); const int Rb = Epi::PERM ? ((R & ~31) + perm32(R & 31)) : R;
        voffA[i] = (unsigned)(R * g.lda + C) * 2u; voffB[i] = (unsigned)(Rb * g.ldb + C) * 2u; }
    const size_t kstep = (size_t)(BK * 2);
    const size_t hstepA = (size_t)HALF * g.lda * 2, hstepB = (size_t)HALF * g.ldb * 2;
    const unsigned ldsw = (unsigned)wid * 1024u;
    const int aoff = lds_byte(wr * 64 + fr, fq * 8), boff = lds_byte(wc * 32 + fr, fq * 8);
#define PG8_SA(b, h) (((b) * 2 + (h)) * HTB)
#define PG8_SB(b, h) ((4 + (b) * 2 + (h)) * HTB)
#define PG8_STAGE(bufoff, gbase, voff) do { _Pragma("unroll") for (int _i = 0; _i < 2; ++_i) \
        __builtin_amdgcn_global_load_lds((const unsigned*)((const char*)(gbase) + (voff)[_i]), (PG8_LAS unsigned*)(lds + (bufoff) + ldsw + _i * 8192), 16, 0, 0); } while (0)
#define PG8_LDA(dst, b, h) do { if constexpr (F8) { _Pragma("unroll") for (int m = 0; m < 4; ++m) dst##8[m] = ld8(lds + PG8_SA(b, h) + aoff + m * 2048); } else { _Pragma("unroll") for (int m = 0; m < 4; ++m) _Pragma("unroll") for (int k = 0; k < 2; ++k) dst[m][k] = *(const PG8_LAS bf16x8*)(lds + PG8_SA(b, h) + aoff + m * 2048 + k * 1024); } } while (0)
#define PG8_LDB(dst, b, h) do { if constexpr (F8) { _Pragma("unroll") for (int n = 0; n < 2; ++n) dst##8[n] = ld8(lds + PG8_SB(b, h) + boff + n * 2048); } else { _Pragma("unroll") for (int n = 0; n < 2; ++n) _Pragma("unroll") for (int k = 0; k < 2; ++k) dst[n][k] = *(const PG8_LAS bf16x8*)(lds + PG8_SB(b, h) + boff + n * 2048 + k * 1024); } } while (0)
#define PG8_MMA(ai, bj, At, Bt) do { __builtin_amdgcn_s_setprio(1); if constexpr (F8 == 2) { _Pragma("unroll") for (int m = 0; m < 4; ++m) _Pragma("unroll") for (int n = 0; n < 2; ++n) \
        asm volatile("s_nop 1\n\tv_mfma_scale_f32_16x16x128_f8f6f4 %0, %1, %2, %0, %3, %4 op_sel_hi:[0,0,0] cbsz:2 blgp:2" : "+v"(acc[ai][bj][m][n]) : "v"(lo6(Bt##8[n])), "v"(lo6(At##8[m])), "v"(Bt##8[n][6]), "v"(At##8[m][6])); } else if constexpr (F8 == 1) { _Pragma("unroll") for (int m = 0; m < 4; ++m) _Pragma("unroll") for (int n = 0; n < 2; ++n) \
        asm volatile("s_nop 1\n\tv_mfma_scale_f32_16x16x128_f8f6f4 %0, %1, %2, %0, %3, %3 op_sel_hi:[0,0,0]" : "+v"(acc[ai][bj][m][n]) : "v"(Bt##8[n]), "v"(At##8[m]), "v"(scl8)); } else { \
        _Pragma("unroll") for (int m = 0; m < 4; ++m) _Pragma("unroll") for (int n = 0; n < 2; ++n) _Pragma("unroll") for (int k = 0; k < 2; ++k) \
        acc[ai][bj][m][n] = __builtin_amdgcn_mfma_f32_16x16x32_bf16(Bt[n][k], At[m][k], acc[ai][bj][m][n], 0, 0, 0); } __builtin_amdgcn_s_setprio(0); } while (0)
#define PG8_WAIT_V(n) asm volatile("s_waitcnt vmcnt(" #n ")" ::: "memory")
#define PG8_WAIT_L(n) asm volatile("s_waitcnt lgkmcnt(" #n ")" ::: "memory")
#define PG8_BAR __builtin_amdgcn_s_barrier()
#define PG8_SCHED __builtin_amdgcn_sched_barrier(0)
    Unit cur, nxt; int ui = 0;
    if (!S.next(0, cur)) return;
    f32x4 acc[2][2][4][2];
#pragma unroll
    for (int a = 0; a < 2; ++a)
#pragma unroll
        for (int b = 0; b < 2; ++b)
#pragma unroll
            for (int m = 0; m < 4; ++m)
#pragma unroll
                for (int n = 0; n < 2; ++n) acc[a][b][m][n] = (f32x4){0.f, 0.f, 0.f, 0.f};
    bf16x8 At[4][2], B0[2][2], B1[2][2]; v8i_t At8[4], B08[2], B18[2]; int scl8 = 0x7F7F7F7F; asm volatile("" : "+v"(scl8));
    const char* cA = (const char*)(g.A + (size_t)cur.z * g.sAz + (size_t)cur.pm * BM * g.lda); const char* cB = (const char*)(g.Bt + (size_t)cur.z * g.sBz + (size_t)cur.pn * BM * g.ldb);
    typename epi_state<Epi>::type est; if constexpr (epi_state<Epi>::has) E.prefetch(est, cur, wr, wc, fr, fq);
    S.a_ready(cur);
    if constexpr (SP2) {
        PG8_STAGE(PG8_SB(0, 0), cB, voffB); PG8_STAGE(PG8_SB(0, 1), cB + hstepB, voffB); PG8_STAGE(PG8_SA(0, 0), cA, voffA); PG8_STAGE(PG8_SA(0, 1), cA + hstepA, voffA);
        if (wr == 1) PG8_BAR;
        PG8_WAIT_V(2); PG8_BAR;
        PG8_STAGE(PG8_SB(1, 0), cB + kstep, voffB); PG8_STAGE(PG8_SA(1, 0), cA + kstep, voffA); PG8_STAGE(PG8_SB(1, 1), cB + hstepB + kstep, voffB);
        PG8_WAIT_V(6); PG8_BAR;
    } else {
        PG8_STAGE(PG8_SB(0, 0), cB, voffB); PG8_STAGE(PG8_SA(0, 0), cA, voffA); PG8_STAGE(PG8_SB(0, 1), cB + hstepB, voffB); PG8_STAGE(PG8_SA(0, 1), cA + hstepA, voffA);
        if (wr == 1) PG8_BAR;
        PG8_WAIT_V(4); PG8_BAR;
        PG8_STAGE(PG8_SB(1, 0), cB + kstep, voffB); PG8_STAGE(PG8_SA(1, 0), cA + kstep, voffA); PG8_STAGE(PG8_SB(1, 1), cB + hstepB + kstep, voffB);
        PG8_WAIT_V(6); PG8_BAR;
    }
    for (;;) {
        const bool has_next = S.next(ui + 1, nxt);
        const char* nA = has_next ? (const char*)(g.A + (size_t)nxt.z * g.sAz + (size_t)nxt.pm * BM * g.lda) : cA; const char* nB = has_next ? (const char*)(g.Bt + (size_t)nxt.z * g.sBz + (size_t)nxt.pn * BM * g.ldb) : cB;
        for (int t = 0; t < nt; t += 2) {
            const bool last = (t == nt - 2);
            const char* a1 = cA + (size_t)(t + 1) * kstep;
            const char* a2 = last ? nA : cA + (size_t)(t + 2) * kstep; const char* b2 = last ? nB : cB + (size_t)(t + 2) * kstep;
            const char* a3 = a2 + kstep; const char* b3 = b2 + kstep;
            if (last && has_next) S.a_ready(nxt);
            if constexpr (SP2) {
            PG8_LDB(B0, 0, 0); PG8_LDB(B1, 0, 1); PG8_SCHED; PG8_LDA(At, 0, 0); PG8_STAGE(PG8_SA(1, 1), a1 + hstepA, voffA);
            PG8_WAIT_V(8); PG8_WAIT_L(0); PG8_BAR; PG8_MMA(0, 0, At, B0); PG8_MMA(0, 1, At, B1); PG8_BAR; PG8_SCHED;
            PG8_LDA(At, 0, 1); PG8_STAGE(PG8_SB(0, 0), b2, voffB); PG8_STAGE(PG8_SB(0, 1), b2 + hstepB, voffB); PG8_STAGE(PG8_SA(0, 0), a2, voffA);
            PG8_WAIT_V(8); PG8_WAIT_L(0); PG8_BAR; PG8_MMA(1, 0, At, B0); PG8_MMA(1, 1, At, B1); PG8_BAR; PG8_SCHED;
            PG8_LDB(B0, 1, 0); PG8_LDB(B1, 1, 1); PG8_SCHED; PG8_LDA(At, 1, 0); PG8_STAGE(PG8_SA(0, 1), a2 + hstepA, voffA);
            PG8_WAIT_V(8); PG8_WAIT_L(0); PG8_BAR; PG8_MMA(0, 0, At, B0); PG8_MMA(0, 1, At, B1); PG8_BAR; PG8_SCHED;
            PG8_LDA(At, 1, 1); PG8_STAGE(PG8_SB(1, 0), b3, voffB); PG8_STAGE(PG8_SB(1, 1), b3 + hstepB, voffB); PG8_STAGE(PG8_SA(1, 0), a3, voffA);
            PG8_WAIT_V(8); PG8_WAIT_L(0); PG8_BAR; PG8_MMA(1, 0, At, B0); PG8_MMA(1, 1, At, B1); PG8_BAR; PG8_SCHED;
            } else {
            PG8_LDB(B0, 0, 0); PG8_SCHED; PG8_LDA(At, 0, 0); PG8_STAGE(PG8_SA(1, 1), a1 + hstepA, voffA);
            PG8_WAIT_L(8); PG8_BAR; PG8_WAIT_L(0); PG8_MMA(0, 0, At, B0); PG8_BAR; PG8_SCHED;
            PG8_LDB(B1, 0, 1); PG8_STAGE(PG8_SB(0, 0), b2, voffB);
            PG8_BAR; PG8_WAIT_L(0); PG8_MMA(0, 1, At, B1); PG8_BAR;
            PG8_LDA(At, 0, 1); PG8_STAGE(PG8_SA(0, 0), a2, voffA);
            PG8_BAR; PG8_WAIT_L(0); PG8_MMA(1, 0, At, B0); PG8_BAR; PG8_SCHED;
            PG8_STAGE(PG8_SB(0, 1), b2 + hstepB, voffB);
            PG8_WAIT_V(6); PG8_BAR; PG8_MMA(1, 1, At, B1); PG8_BAR;
            PG8_LDB(B0, 1, 0); PG8_SCHED; PG8_LDA(At, 1, 0); PG8_STAGE(PG8_SA(0, 1), a2 + hstepA, voffA);
            PG8_WAIT_L(8); PG8_BAR; PG8_WAIT_L(0); PG8_MMA(0, 0, At, B0); PG8_BAR; PG8_SCHED;
            PG8_LDB(B1, 1, 1); PG8_STAGE(PG8_SB(1, 0), b3, voffB);
            PG8_BAR; PG8_WAIT_L(0); PG8_MMA(0, 1, At, B1); PG8_BAR;
            PG8_LDA(At, 1, 1); PG8_STAGE(PG8_SA(1, 0), a3, voffA);
            PG8_BAR; PG8_WAIT_L(0); PG8_MMA(1, 0, At, B0); PG8_BAR; PG8_SCHED;
            PG8_STAGE(PG8_SB(1, 1), b3 + hstepB, voffB);
            PG8_WAIT_V(6); PG8_BAR; PG8_MMA(1, 1, At, B1); PG8_BAR;
            }
        }
        if constexpr (F8) asm volatile("s_nop 15\n\ts_nop 7" ::: "memory");
        if constexpr (ALIGN_EPI) { if (wr == 0) PG8_BAR; }
        if constexpr (!Epi::AFTER_DRAIN) { if constexpr (epi_state<Epi>::has) E(acc, cur, wr, wc, fr, fq, est); else E(acc, cur, wr, wc, fr, fq); S.done(cur); }
        if (!has_next) break;
#pragma unroll
        for (int a = 0; a < 2; ++a)
#pragma unroll
            for (int b = 0; b < 2; ++b)
#pragma unroll
                for (int m = 0; m < 4; ++m)
#pragma unroll
                    for (int n = 0; n < 2; ++n) acc[a][b][m][n] = (f32x4){0.f, 0.f, 0.f, 0.f};
        cur = nxt; cA = nA; cB = nB; ++ui; if constexpr (epi_state<Epi>::has) E.prefetch(est, cur, wr, wc, fr, fq);
        if constexpr (ALIGN_EPI) { if (wr == 1) PG8_BAR; }
    }
    PG8_WAIT_V(0);
    if constexpr (!ALIGN_EPI) { if (wr == 0) PG8_BAR; }
    PG8_BAR;
    if constexpr (Epi::AFTER_DRAIN) { E.fused(acc, cur, wr, wc, fr, fq, lds, wid, lane); S.done(cur); }
#undef PG8_SA
#undef PG8_SB
#undef PG8_STAGE
#undef PG8_LDA
#undef PG8_LDB
#undef PG8_MMA
#undef PG8_WAIT_V
#undef PG8_WAIT_L
#undef PG8_BAR
#undef PG8_SCHED
}
}


constexpr int T_ = 8192, DM = 4096, INW = 14336;
constexpr int MH = 16, MW = 2048, NBLK = 32;
constexpr int RH = 8;
constexpr int PH = 8, NEXP = 16384;
constexpr float NORM_EPS = 1e-6f, GN_EPS = 1e-6f;
constexpr float LOG2E = 1.4426950408889634f;
constexpr float QSCALE = 0.08838834764831845f * 1.4426950408889634f;

constexpr size_t MiB = 1u << 20;
constexpr size_t WS_CTL = 0, CTL_ZERO_BYTES = 1 * MiB;
constexpr size_t WS_TAB = 1 * MiB;
constexpr size_t TAB_BIAS = WS_TAB, TAB_KMEAN = WS_TAB + 65536, TAB_KEYS = WS_TAB + 524288;
constexpr size_t WS_ROPE = 2 * MiB;
constexpr size_t WS_WIN_T = 10 * MiB;
constexpr size_t WS_WIN8 = WS_WIN_T, WS_WINB = WS_WIN_T + 24 * MiB;
constexpr size_t WS_PROJ = 122 * MiB;
constexpr size_t PROJ_STRIDE = (size_t)T_ * 2048;
constexpr size_t WS_XN = 346 * MiB;
constexpr size_t WS_MIX = 410 * MiB;
constexpr size_t WS_WOUT_T = 474 * MiB;
constexpr size_t WS_WQ_T = 506 * MiB;
constexpr size_t WS_H1 = 522 * MiB;
constexpr size_t WS_U8 = 650 * MiB;
constexpr size_t WS_V8T = 714 * MiB;
constexpr size_t WS_W8 = 778 * MiB;
constexpr size_t WS_FREE = 906 * MiB;
constexpr size_t WS_END = 1024 * MiB;
constexpr size_t WS_PQ = WS_WIN_T;
constexpr size_t WS_KT = WS_WIN_T + 64 * MiB;
constexpr size_t WS_UT = WS_XN;
constexpr size_t WS_VS = WS_FREE;
constexpr size_t WS_LIST = WS_FREE + 64 * MiB;
constexpr size_t WS_ML = WS_FREE + 80 * MiB;
constexpr size_t WS_PART = WS_H1;
constexpr size_t WS_GW = WS_WIN_T;
constexpr size_t WS_PQP = WS_WIN_T + 256 * MiB;
constexpr size_t WS_XN8 = 410 * MiB;
constexpr size_t WS_BM = WS_FREE + 32 * MiB;
constexpr size_t WS_TN8 = WS_FREE;
constexpr float WIN8_SCALE = 1024.f, XN8_SCALE = 16.f;
constexpr float TN8_SCALE = 16.f, U8_SCALE = 1024.f, V8_SCALE = 32.f, W8_SCALE = 32.f;
static_assert(WS_PQP + 32 * MiB <= WS_XN && WS_ML + 4 * MiB <= WS_END && WS_KT + 32 * MiB <= WS_PROJ, "d_ws map");
constexpr int CW_BAR = 4096;
constexpr int CW_CNT = 16384;

constexpr int RING_BYTES = 155648;
constexpr int LDSCTL_OFF = RING_BYTES, MISC_OFF = LDSCTL_OFF + 64;
constexpr int LDS_BYTES = RING_BYTES + 256;

#define GAS __attribute__((address_space(1)))
#define LAS __attribute__((address_space(3)))
typedef unsigned short bf16;
typedef unsigned v4u __attribute__((ext_vector_type(4)));
typedef unsigned v2u __attribute__((ext_vector_type(2)));
typedef float f32x4 __attribute__((ext_vector_type(4)));
typedef float f32x2 __attribute__((ext_vector_type(2)));
typedef float f32x16 __attribute__((ext_vector_type(16)));
typedef short bf16x8 __attribute__((ext_vector_type(8)));
typedef short s16x4 __attribute__((ext_vector_type(4)));
typedef short s16x2 __attribute__((ext_vector_type(2)));
typedef short v4i16_t __attribute__((ext_vector_type(4)));
#define LDS_WAIT() asm volatile("s_waitcnt lgkmcnt(0)" ::: "memory")
#define VM_WAIT() asm volatile("s_waitcnt vmcnt(0)" ::: "memory")
__device__ __forceinline__ unsigned f2bf(float f) { unsigned u = __builtin_bit_cast(unsigned, f); return (u + 0x7fffu + ((u >> 16) & 1u)) >> 16; }
__device__ __forceinline__ unsigned pk2(float lo, float hi) { return f2bf(lo) | (f2bf(hi) << 16); }
__device__ __forceinline__ float clamp448(float x) { return __builtin_fminf(__builtin_fmaxf(x, -448.f), 448.f); }
__device__ __forceinline__ unsigned pk4_fp8(float a, float b, float c, float d) { int r = 0; r = __builtin_amdgcn_cvt_pk_fp8_f32(clamp448(a), clamp448(b), r, false); r = __builtin_amdgcn_cvt_pk_fp8_f32(clamp448(c), clamp448(d), r, true); return (unsigned)r; }
__device__ __forceinline__ float bflo(unsigned w) { return __builtin_bit_cast(float, w << 16); }
__device__ __forceinline__ float bfhi(unsigned w) { return __builtin_bit_cast(float, w & 0xffff0000u); }

#define XB_TMO      128
#define XB_XCNT(j)  (256  + 64 * (j))
#define XB_XSUB(j)  (1280 + 64 * (j))
#define XB_XGEN(j)  (2304 + 64 * (j))
#define XB_TOP      3328
#define XB_TOPGEN   3392
#define XCD_BAR_WORDS 3456
#define XB_SPIN_CAP (1u << 18)

__device__ __forceinline__ unsigned xb_ld(unsigned* p)              { return __hip_atomic_load(p, __ATOMIC_RELAXED, __HIP_MEMORY_SCOPE_AGENT); }
__device__ __forceinline__ unsigned xb_add(unsigned* p, unsigned v) { return __hip_atomic_fetch_add(p, v, __ATOMIC_RELAXED, __HIP_MEMORY_SCOPE_AGENT); }
__device__ __forceinline__ unsigned xb_xcc_id() { return (unsigned)__builtin_amdgcn_s_getreg((3 << 11) | 20) & 0xFu; }
#define XB_SPIN(cond, bar) do { unsigned _sp = 0; while (cond) { __builtin_amdgcn_s_sleep(1); \
    if ((++_sp & 255u) == 0u) { if (xb_ld(&(bar)[XB_TMO])) break; if (_sp > XB_SPIN_CAP) { atomicAdd(&(bar)[XB_TMO], 1u); break; } } } } while (0)

struct XcdBarrier {
    unsigned* bar; unsigned x;
    volatile LAS unsigned* st;
};

__device__ __forceinline__ XcdBarrier xcd_barrier_post(unsigned* bar, volatile LAS unsigned* st) {
    XcdBarrier b; b.bar = bar; b.x = xb_xcc_id(); b.st = st;
    if (threadIdx.x == 0) (void)xb_add(&bar[XB_XCNT(b.x)], 1u);
    return b;
}
__device__ __forceinline__ void xcd_barrier_complete(unsigned* bar, unsigned x, unsigned& nloc, unsigned& nx) {
    const unsigned G = gridDim.x * gridDim.y * gridDim.z;
    unsigned sum, cnt, mine, sp = 0u;
    for (;;) {
        sum = 0u; cnt = 0u; mine = 0u;
#pragma unroll
        for (unsigned j = 0; j < 16; ++j) { const unsigned c = xb_ld(&bar[XB_XCNT(j)]); sum += c; cnt += (c > 0u) ? 1u : 0u; mine = (j == x) ? c : mine; }
        if (sum == G) break;
        __builtin_amdgcn_s_sleep(1);
        if ((++sp & 255u) == 0u) { if (xb_ld(&bar[XB_TMO])) break; if (sp > XB_SPIN_CAP) { atomicAdd(&bar[XB_TMO], 1u); break; } }
    }
    nloc = mine > 0u ? mine : 1u; nx = cnt > 0u ? cnt : 1u;
}

__device__ __forceinline__ void xcd_barrier(const XcdBarrier& b) {
    asm volatile("s_waitcnt vmcnt(0)" ::: "memory");
    __syncthreads();
    if (threadIdx.x == 0) {
        unsigned* bar = b.bar;
        __builtin_amdgcn_s_waitcnt(0);
        unsigned nloc = b.st[0], nx = b.st[1];
        if (nloc == 0u) { xcd_barrier_complete(bar, b.x, nloc, nx); b.st[0] = nloc; b.st[1] = nx; }
        const unsigned old = xb_add(&bar[XB_XSUB(b.x)], 1u);
        const unsigned gen = old / nloc;
        if (old + 1u == (gen + 1u) * nloc) {
            __builtin_amdgcn_fence(__ATOMIC_RELEASE, "agent");
            asm volatile("s_waitcnt vmcnt(0)" ::: "memory");
            const unsigned og = xb_add(&bar[XB_TOP], 1u);
            const unsigned tg = og / nx;
            if (og + 1u == (tg + 1u) * nx) xb_add(&bar[XB_TOPGEN], 1u);
            else XB_SPIN(xb_ld(&bar[XB_TOPGEN]) == tg, bar);
            __builtin_amdgcn_fence(__ATOMIC_ACQUIRE, "agent");
            xb_add(&bar[XB_XGEN(b.x)], 1u);
            asm volatile("s_waitcnt vmcnt(0)" ::: "memory");
        } else {
            XB_SPIN(xb_ld(&bar[XB_XGEN(b.x)]) == gen, bar);
            __builtin_amdgcn_fence(__ATOMIC_ACQUIRE, "agent");
            asm volatile("s_waitcnt vmcnt(0)" ::: "memory");
        }
    }
    __syncthreads();
}


struct Frame {
    LAS unsigned char* lds;
    int tid, lane, wave, G, gw, NGW;
};
__device__ __forceinline__ float wave_sum(float v) {
#pragma unroll
    for (int o = 1; o < 64; o <<= 1) v += __shfl_xor(v, o);
    return v;
}

__device__ __forceinline__ void p0_transpose_item(const float* W, int K, int N, int ldw, bf16* WT, LAS float* scr, int item, int lane) {
    const int nblk = N / 64, kb = item / nblk, nb = item % nblk, k0 = 64 * kb, n0 = 64 * nb;
    { const int c4 = lane & 15, kr = lane >> 4; f32x4 v[16];
#pragma unroll
      for (int i = 0; i < 16; ++i) v[i] = *(const GAS f32x4*)(W + (size_t)(k0 + 4 * i + kr) * ldw + n0 + 4 * c4);
#pragma unroll
      for (int i = 0; i < 16; ++i) { const int k = 4 * i + kr; *(LAS f32x4*)(scr + k * 64 + ((c4 ^ ((k >> 3) & 15)) << 2)) = v[i]; } }
    LDS_WAIT(); asm volatile("" ::: "memory");
    const int c = lane & 7;
#pragma unroll
    for (int j = 0; j < 8; ++j) { const int n = (lane >> 3) + 8 * j; const LAS float* p = scr + (8 * c) * 64 + ((((n >> 2) ^ c) & 15) << 2) + (n & 3);
        v4u o; o.x = pk2(p[0 * 64], p[1 * 64]); o.y = pk2(p[2 * 64], p[3 * 64]); o.z = pk2(p[4 * 64], p[5 * 64]); o.w = pk2(p[6 * 64], p[7 * 64]);
        *(GAS v4u*)(WT + (size_t)(n0 + n) * K + k0 + 8 * c) = o; }
    LDS_WAIT(); asm volatile("" ::: "memory");
}
__device__ __forceinline__ void p0_transpose_item_fp8(const float* W, int K, int N, int ldw, unsigned char* WT, float scale, LAS float* scr, int item, int lane) {
    const int nblk = N / 32, kb = item / nblk, nb = item % nblk, k0 = 128 * kb, n0 = 32 * nb;
    { const int c4 = lane & 7, kr = lane >> 3; f32x4 v[16];
#pragma unroll
      for (int i = 0; i < 16; ++i) v[i] = *(const GAS f32x4*)(W + (size_t)(k0 + 8 * i + kr) * ldw + n0 + 4 * c4);
#pragma unroll
      for (int i = 0; i < 16; ++i) { const int k = 8 * i + kr; *(LAS f32x4*)(scr + k * 32 + ((c4 ^ ((k >> 4) & 7)) << 2)) = v[i] * scale; } }
    LDS_WAIT(); asm volatile("" ::: "memory");
    const int c = lane & 7;
#pragma unroll
    for (int j = 0; j < 4; ++j) { const int n = (lane >> 3) + 8 * j; const LAS float* p = scr + (16 * c) * 32 + ((((n >> 2) ^ c) & 7) << 2) + (n & 3);
        v4u o; o.x = pk4_fp8(p[0 * 32], p[1 * 32], p[2 * 32], p[3 * 32]); o.y = pk4_fp8(p[4 * 32], p[5 * 32], p[6 * 32], p[7 * 32]);
        o.z = pk4_fp8(p[8 * 32], p[9 * 32], p[10 * 32], p[11 * 32]); o.w = pk4_fp8(p[12 * 32], p[13 * 32], p[14 * 32], p[15 * 32]);
        *(GAS v4u*)(WT + (size_t)(n0 + n) * K + k0 + 16 * c) = o; }
    LDS_WAIT(); asm volatile("" ::: "memory");
}
template <int MODE> __device__ __forceinline__ void rms_row_to_bf16(int lane, const float* xrow, const float* g, bf16* orow, unsigned char* o8row = nullptr) {
    const GAS f32x4* xr = (const GAS f32x4*)xrow + lane; const GAS f32x4* gr = (const GAS f32x4*)g + lane;
    f32x4 v[16]; float s = 0.f;
#pragma unroll
    for (int j = 0; j < 16; ++j) { v[j] = xr[64 * j]; s += (v[j].x * v[j].x + v[j].y * v[j].y) + (v[j].z * v[j].z + v[j].w * v[j].w); }
    const float rstd = 1.f / sqrtf(wave_sum(s) * (1.f / DM) + NORM_EPS);
    GAS v2u* o8 = (GAS v2u*)orow + lane;
#pragma unroll
    for (int j = 0; j < 16; ++j) { const f32x4 gg = gr[64 * j]; const f32x4 y = v[j] * rstd * gg; if constexpr (MODE != 2) { v2u w; w.x = pk2(y.x, y.y); w.y = pk2(y.z, y.w); o8[64 * j] = w; }
        if constexpr (MODE != 0) { const f32x4 ys = y * 16.f; ((GAS unsigned*)o8row)[lane + 64 * j] = pk4_fp8(ys.x, ys.y, ys.z, ys.w); } }
}
__constant__ unsigned char T5_BUCKET[129] = {0, 1, 2, 3, 4, 5, 6, 7, 8, 9, 10, 11, 12, 13, 14, 15, 16, 16, 16, 17, 17, 18, 18, 18, 19, 19, 19, 20, 20, 20, 20, 21, 21, 21, 21, 22, 22, 22, 22, 22, 23, 23, 23, 23, 23, 23, 24, 24, 24, 24, 24, 24, 25, 25, 25, 25, 25, 25, 25, 26, 26, 26, 26, 26, 26, 26, 26, 27, 27, 27, 27, 27, 27, 27, 27, 27, 27, 28, 28, 28, 28, 28, 28, 28, 28, 28, 28, 29, 29, 29, 29, 29, 29, 29, 29, 29, 29, 29, 29, 30, 30, 30, 30, 30, 30, 30, 30, 30, 30, 30, 30, 30, 30, 31, 31, 31, 31, 31, 31, 31, 31, 31, 31, 31, 31, 31, 31, 31, 31};

struct Args { const float* in[11]; float* out; unsigned char* ws; int ph_lo, ph_hi; };

__device__ __forceinline__ void p0_prologue(Frame& F, const Args& a) {
    unsigned char* ws = a.ws;
    LAS float* scr = (LAS float*)(F.lds + F.wave * 16384);
    const int gw = F.gw, NGW = F.NGW;
    const float* w_in = a.in[2]; const float* w_out = a.in[3]; const float* w_q = a.in[6]; const float* pv = a.in[9];
    constexpr int NMOBA = 3 * MW, NRET = INW - NMOBA;
    constexpr int I_INA = (DM / 128) * (NMOBA / 32), I_INB = (DM / 64) * (NRET / 64), I_OUT = (DM / 64) * (DM / 64), I_Q = (DM / 64) * (2048 / 64), I_V = (NEXP / 128) * (DM / 32);
    constexpr int NITEMS = I_INA + I_INB + I_OUT + I_Q + I_V;
    for (int it = gw; it < NITEMS; it += NGW) {
        int r = it;
        if (r < I_INA) { p0_transpose_item_fp8(w_in, DM, NMOBA, INW, ws + WS_WIN8, WIN8_SCALE, scr, r, F.lane); continue; } r -= I_INA;
        if (r < I_INB) { p0_transpose_item(w_in + NMOBA, DM, NRET, INW, (bf16*)(ws + WS_WINB), scr, r, F.lane); continue; } r -= I_INB;
        if (r < I_OUT) { p0_transpose_item(w_out, DM, DM, DM, (bf16*)(ws + WS_WOUT_T), scr, r, F.lane); continue; } r -= I_OUT;
        if (r < I_Q) { p0_transpose_item(w_q, DM, 2048, 2048, (bf16*)(ws + WS_WQ_T), scr, r, F.lane); continue; } r -= I_Q;
        p0_transpose_item_fp8(pv, NEXP, DM, DM, ws + WS_V8T, V8_SCALE, scr, r, F.lane);
    }
    { const GAS f32x4* src = (const GAS f32x4*)a.in[8]; GAS v4u* dst = (GAS v4u*)(ws + WS_U8);
      const size_t n16 = (size_t)NEXP * DM / 16, stride = (size_t)NGW * 64;
      for (size_t i0 = (size_t)gw * 64 + F.lane; i0 < n16; i0 += 4 * stride) { f32x4 x[4][4];
#pragma unroll
          for (int r = 0; r < 4; ++r) { const size_t i = i0 + r * stride; if (i < n16) {
#pragma unroll
              for (int q = 0; q < 4; ++q) x[r][q] = src[4 * i + q]; } }
#pragma unroll
          for (int r = 0; r < 4; ++r) { const size_t i = i0 + r * stride; if (i < n16) { v4u o;
              o.x = pk4_fp8(x[r][0].x * U8_SCALE, x[r][0].y * U8_SCALE, x[r][0].z * U8_SCALE, x[r][0].w * U8_SCALE); o.y = pk4_fp8(x[r][1].x * U8_SCALE, x[r][1].y * U8_SCALE, x[r][1].z * U8_SCALE, x[r][1].w * U8_SCALE);
              o.z = pk4_fp8(x[r][2].x * U8_SCALE, x[r][2].y * U8_SCALE, x[r][2].z * U8_SCALE, x[r][2].w * U8_SCALE); o.w = pk4_fp8(x[r][3].x * U8_SCALE, x[r][3].y * U8_SCALE, x[r][3].z * U8_SCALE, x[r][3].w * U8_SCALE); dst[i] = o; } } } }
    { const GAS f32x4* src = (const GAS f32x4*)a.in[7]; GAS v4u* dst = (GAS v4u*)(ws + TAB_KEYS);
      const size_t n8 = (size_t)262144 / 8, stride = (size_t)NGW * 64;
      for (size_t i = (size_t)gw * 64 + F.lane; i < n8; i += stride) { const f32x4 x0 = src[2 * i], x1 = src[2 * i + 1]; v4u o; o.x = pk2(x0.x, x0.y); o.y = pk2(x0.z, x0.w); o.z = pk2(x1.x, x1.y); o.w = pk2(x1.z, x1.w); dst[i] = o; } }
    for (int m = gw; m < T_; m += NGW) rms_row_to_bf16<1>(F.lane, a.in[0] + (size_t)m * DM, a.in[1], (bf16*)(ws + WS_XN) + (size_t)m * DM, ws + WS_XN8 + (size_t)m * DM);
    { float* COS = (float*)(ws + WS_ROPE); float* SIN = COS + (size_t)T_ * 128;
      for (int i = gw * 64 + F.lane; i < T_ * 128; i += NGW * 64) { const int t = i >> 7, f = i & 127;
          const double inv = exp2(-(double)f * (13.287712379549449 / 128.0));
          const double rev = (double)t * inv * 0.15915494309189535;
          const float fr = (float)(rev - floor(rev));
          COS[i] = __builtin_amdgcn_cosf(fr); SIN[i] = __builtin_amdgcn_sinf(fr); } }
    { float* tb = (float*)(ws + TAB_BIAS); const float* rb = a.in[4];
      for (int i = gw * 64 + F.lane; i < 16 * 132; i += NGW * 64) { const int h = i / 132, n = i % 132; tb[i] = rb[(int)T5_BUCKET[n > 128 ? 128 : n] * 16 + h] * LOG2E; } }
}

namespace pg8 {
struct EpiResF32 {
    static constexpr bool PERM = false, AFTER_DRAIN = false;
    const float* base; float* C; int ldc; float scale;
    __device__ __forceinline__ void operator()(const f32x4 (&acc)[2][2][4][2], const Unit& u, int wr, int wc, int fr, int fq) const {
        const int row0 = u.pm * BM + wr * 64 + fr, col0 = u.pn * BM + wc * 32 + 4 * fq;
#pragma unroll
        for (int ai = 0; ai < 2; ++ai)
#pragma unroll
            for (int m = 0; m < 4; ++m) { const size_t off = (size_t)(row0 + ai * HALF + m * 16) * ldc + col0;
#pragma unroll
                for (int bj = 0; bj < 2; ++bj)
#pragma unroll
                    for (int n = 0; n < 2; ++n) { const f32x4 b = *(const f32x4*)(base + off + bj * HALF + n * 16); *(f32x4*)(C + off + bj * HALF + n * 16) = acc[ai][bj][m][n] * scale + b; } }
    }
};
struct EpiF32Z {
    static constexpr bool PERM = false, AFTER_DRAIN = false;
    float* C;
    __device__ __forceinline__ void operator()(const f32x4 (&acc)[2][2][4][2], const Unit& u, int wr, int wc, int fr, int fq) const {
        float* Cz = C + (size_t)u.z * 65536; const int row0 = wr * 64 + fr, col0 = wc * 32 + 4 * fq;
#pragma unroll
        for (int ai = 0; ai < 2; ++ai)
#pragma unroll
            for (int m = 0; m < 4; ++m) { float* rowp = Cz + (size_t)(row0 + ai * HALF + m * 16) * 256 + col0;
#pragma unroll
                for (int bj = 0; bj < 2; ++bj)
#pragma unroll
                    for (int n = 0; n < 2; ++n) *(f32x4*)(rowp + bj * HALF + n * 16) = acc[ai][bj][m][n]; }
    }
};
struct EpiRetP {
    static constexpr bool PERM = true, AFTER_DRAIN = false;
    bf16_t* PQ;
    __device__ __forceinline__ void operator()(const f32x4 (&acc)[2][2][4][2], const Unit& u, int wr, int wc, int fr, int fq) const {
        asm volatile("" : "+v"(fr), "+v"(fq));
        const int h = u.z; const float lg = __builtin_log2f(1.f - __builtin_exp2f(-5.f - (float)h));
        bf16_t* base = PQ + (size_t)(u.z * 32 + u.pm) * 131072;
#pragma unroll
        for (int ai = 0; ai < 2; ++ai)
#pragma unroll
            for (int m = 0; m < 4; ++m) { int i = ai * HALF + wr * 64 + m * 16 + fr;
                float lgv = lg; asm volatile("" : "+v"(lgv), "+v"(i));
#pragma unroll
                for (int bj = 0; bj < 2; ++bj) { const int j0 = bj * HALF + wc * 32 + 8 * fq; float v[8];
#pragma unroll
                    for (int e = 0; e < 8; ++e) { const int dd = i - (j0 + e); const float a = e < 4 ? acc[ai][bj][m][0][e & 3] : acc[ai][bj][m][1][e & 3];
                        v[e] = dd >= 0 ? a * __builtin_amdgcn_exp2f((float)dd * lgv) : 0.f; }
                    u32x4 w; w.x = cvt_pk_bf16(v[0], v[1]); w.y = cvt_pk_bf16(v[2], v[3]); w.z = cvt_pk_bf16(v[4], v[5]); w.w = cvt_pk_bf16(v[6], v[7]);
                    *(u32x4*)(base + (size_t)i * 512 + j0) = w; } }
    }
};
struct EpiRetOut {
    static constexpr bool PERM = true, AFTER_DRAIN = true;
    const bf16_t* RG; bf16_t* MIX;
    __device__ __forceinline__ void fused(f32x4 (&acc)[2][2][4][2], const Unit& u, int wr, int wc, int fr, int fq, PG8_LAS unsigned char* lds, int wid, int lane) const {
        PG8_LAS f32x2* P = (PG8_LAS f32x2*)lds;
#pragma unroll
        for (int ai = 0; ai < 2; ++ai)
#pragma unroll
            for (int m = 0; m < 4; ++m) { float s = 0.f, q = 0.f;
#pragma unroll
                for (int bj = 0; bj < 2; ++bj)
#pragma unroll
                    for (int n = 0; n < 2; ++n) { const f32x4 x = acc[ai][bj][m][n]; s += (x[0] + x[1]) + (x[2] + x[3]); q += (x[0] * x[0] + x[1] * x[1]) + (x[2] * x[2] + x[3] * x[3]); }
                s += __shfl_xor(s, 16); s += __shfl_xor(s, 32); q += __shfl_xor(q, 16); q += __shfl_xor(q, 32);
                if (fq == 0) P[(ai * HALF + wr * 64 + m * 16 + fr) * 4 + wc] = (f32x2){s, q}; }
        asm volatile("s_waitcnt lgkmcnt(0)" ::: "memory"); __builtin_amdgcn_s_barrier(); asm volatile("" ::: "memory");
        const int h = u.z >> 5, c = u.z & 31;
#pragma unroll
        for (int ai = 0; ai < 2; ++ai)
#pragma unroll
            for (int m = 0; m < 4; ++m) { const int i = ai * HALF + wr * 64 + m * 16 + fr;
                const f32x2 p0 = P[i * 4 + 0], p1 = P[i * 4 + 1], p2 = P[i * 4 + 2], p3 = P[i * 4 + 3];
                const float mean = ((p0.x + p1.x) + (p2.x + p3.x)) * (1.f / 256.f); float var = ((p0.y + p1.y) + (p2.y + p3.y)) * (1.f / 256.f) - mean * mean; var = var < 0.f ? 0.f : var;
                const float rstd = 1.f / sqrtf(var + 1e-6f);
                const size_t t = (size_t)c * 256 + i;
#pragma unroll
                for (int bj = 0; bj < 2; ++bj) { const int e0 = bj * HALF + wc * 32 + 8 * fq;
                    const u32x4 gw = *(const u32x4*)(RG + t * 2048 + h * 256 + e0); float g[8];
                    g[0] = __builtin_bit_cast(float, gw.x << 16); g[1] = __builtin_bit_cast(float, gw.x & 0xffff0000u); g[2] = __builtin_bit_cast(float, gw.y << 16); g[3] = __builtin_bit_cast(float, gw.y & 0xffff0000u);
                    g[4] = __builtin_bit_cast(float, gw.z << 16); g[5] = __builtin_bit_cast(float, gw.z & 0xffff0000u); g[6] = __builtin_bit_cast(float, gw.w << 16); g[7] = __builtin_bit_cast(float, gw.w & 0xffff0000u);
                    float v[8];
#pragma unroll
                    for (int e = 0; e < 8; ++e) { const float a = e < 4 ? acc[ai][bj][m][0][e & 3] : acc[ai][bj][m][1][e & 3]; const float y = (a - mean) * rstd;
                        const float sg = g[e] * __builtin_amdgcn_rcpf(1.f + __builtin_amdgcn_exp2f(-g[e] * 1.4426950408889634f)); v[e] = y * sg; }
                    u32x4 w; w.x = cvt_pk_bf16(v[0], v[1]); w.y = cvt_pk_bf16(v[2], v[3]); w.z = cvt_pk_bf16(v[4], v[5]); w.w = cvt_pk_bf16(v[6], v[7]);
                    *(u32x4*)(MIX + t * 4096 + 2048 + h * 256 + e0) = w; } }
    }
};
template <int MODE> struct EpiPeerW8 {
    static constexpr bool PERM = true, AFTER_DRAIN = false;
    const bf16_t* G; const unsigned* BMP; unsigned char* W8; float sacc, sw;
    struct State { unsigned bm[8]; };
    __device__ __forceinline__ void prefetch(State& st, const Unit& u, int wr, int wc, int fr, int fq) const {
        const int row0 = u.pm * BM + wr * 64 + fr;
#pragma unroll
        for (int ai = 0; ai < 2; ++ai)
#pragma unroll
            for (int m = 0; m < 4; ++m) st.bm[ai * 4 + m] = MODE == 2 ? 0u : BMP[(size_t)(row0 + ai * HALF + m * 16) * 64 + u.pn];
    }
    __device__ __forceinline__ void operator()(const f32x4 (&acc)[2][2][4][2], const Unit& u, int wr, int wc, int fr, int fq, const State& st) const {
        const int row0 = u.pm * BM + wr * 64 + fr, col0 = u.pn * BM + wc * 32 + 8 * fq;
        typedef unsigned u32x2 __attribute__((ext_vector_type(2)));
#pragma unroll
        for (int ai = 0; ai < 2; ++ai)
#pragma unroll
            for (int m = 0; m < 4; ++m) { const int row = row0 + ai * HALF + m * 16; const size_t ro = (size_t)row * 16384 + col0;
                const unsigned bm = MODE == 2 ? (unsigned)(row * 2654435761u) & (unsigned)((row * 40503u) >> 3) & (unsigned)(row * 97u) : st.bm[ai * 4 + m];
#pragma unroll
                for (int bj = 0; bj < 2; ++bj) { unsigned w0 = 0u, w1 = 0u;
                    if ((bm >> (16 * bj + 4 * wc + fq)) & 1u) {
                        const u32x4 gw = MODE == 2 ? (u32x4){0x3f803f80u, 0x3f803f80u, 0x3f803f80u, 0x3f803f80u} : *(const u32x4*)(G + ro + bj * HALF);
                        const f32x4 v0 = acc[ai][bj][m][0] * sacc, v1 = acc[ai][bj][m][1] * sacc;
                        f32x2 a = (f32x2){v0[0], v0[1]}, b = (f32x2){v0[2], v0[3]}, c = (f32x2){v1[0], v1[1]}, d = (f32x2){v1[2], v1[3]};
                        if constexpr (MODE == 0) { a = gelu_pk(a); b = gelu_pk(b); c = gelu_pk(c); d = gelu_pk(d); }
                        float r[8];
                        r[0] = a.x * __builtin_bit_cast(float, gw.x << 16); r[1] = a.y * __builtin_bit_cast(float, gw.x & 0xffff0000u);
                        r[2] = b.x * __builtin_bit_cast(float, gw.y << 16); r[3] = b.y * __builtin_bit_cast(float, gw.y & 0xffff0000u);
                        r[4] = c.x * __builtin_bit_cast(float, gw.z << 16); r[5] = c.y * __builtin_bit_cast(float, gw.z & 0xffff0000u);
                        r[6] = d.x * __builtin_bit_cast(float, gw.w << 16); r[7] = d.y * __builtin_bit_cast(float, gw.w & 0xffff0000u);
                        int t0 = 0, t1 = 0;
                        t0 = __builtin_amdgcn_cvt_pk_fp8_f32(r[0] * sw, r[1] * sw, t0, false); t0 = __builtin_amdgcn_cvt_pk_fp8_f32(r[2] * sw, r[3] * sw, t0, true);
                        t1 = __builtin_amdgcn_cvt_pk_fp8_f32(r[4] * sw, r[5] * sw, t1, false); t1 = __builtin_amdgcn_cvt_pk_fp8_f32(r[6] * sw, r[7] * sw, t1, true);
                        w0 = (unsigned)t0; w1 = (unsigned)t1; }
                    *(u32x2*)(W8 + ro + bj * HALF) = (u32x2){w0, w1}; } }
    }
};
struct BatchOrder {
    int nz, G, c;
    __device__ bool next(int i, Unit& u) const { const int L = i * G + c; if (L >= nz) return false; u.pm = 0; u.pn = 0; u.z = L; return true; }
    __device__ __forceinline__ void a_ready(const Unit&) const {}
    __device__ __forceinline__ void done(const Unit&) const {}
};
struct HOrder { int G, c; __device__ bool next(int i, Unit& u) const { const int L = i * G + c; if (L >= 256) return false; u.z = L >> 5; u.pm = L & 31; u.pn = L & 31; return true; }
                __device__ __forceinline__ void a_ready(const Unit&) const {} __device__ __forceinline__ void done(const Unit&) const {} };
struct OneOrder { int z; __device__ bool next(int i, Unit& u) const { if (i > 0 || z >= 256) return false; u.pm = 0; u.pn = 0; u.z = z; return true; }
                  __device__ __forceinline__ void a_ready(const Unit&) const {} __device__ __forceinline__ void done(const Unit&) const {} };
}

__device__ __forceinline__ int tr_off(int d, int j) { return d * 512 + ((((j >> 3) ^ (d >> 3)) & 31) << 4) + ((j & 7) << 1); }
__device__ __forceinline__ void unpack8(const v4u w, float (&f)[8]) { f[0] = bflo(w.x); f[1] = bfhi(w.x); f[2] = bflo(w.y); f[3] = bfhi(w.y); f[4] = bflo(w.z); f[5] = bfhi(w.z); f[6] = bflo(w.w); f[7] = bfhi(w.w); }
__device__ __forceinline__ v4u pack8(const float (&f)[8]) { v4u o; o.x = pk2(f[0], f[1]); o.y = pk2(f[2], f[3]); o.z = pk2(f[4], f[5]); o.w = pk2(f[6], f[7]); return o; }

template <bool NOSTORE> __device__ __forceinline__ void p2_prep(Frame& F, unsigned char* ws) {
    bf16* RQ = (bf16*)(ws + WS_PROJ) + 3 * PROJ_STRIDE; bf16* RK = RQ + PROJ_STRIDE; bf16* RV = RK + PROJ_STRIDE;
    const float* COS = (const float*)(ws + WS_ROPE); const float* SIN = COS + (size_t)T_ * 128;
    bf16* PQ = (bf16*)(ws + WS_PQ); bf16* KT = (bf16*)(ws + WS_KT); bf16* VS = (bf16*)(ws + WS_VS);
    LAS unsigned char* Tl = F.lds;
    const int l16 = F.tid & 15, trow = F.tid >> 4, d0 = l16 * 8;
    for (int item = blockIdx.x; item < 256; item += F.G) {
        const int h = item >> 5, c = item & 31;
        const float lg = __builtin_log2f(1.f - __builtin_exp2f(-5.f - (float)h));
#pragma unroll 2
        for (int step = 0; step < 8; ++step) {
            const int j = step * 32 + trow; const size_t t = (size_t)c * 256 + j;
            bf16* kp = RK + t * 2048 + h * 256 + d0;
            float lo[8], hi[8], cs[8], sn[8];
            unpack8(*(const GAS v4u*)kp, lo); unpack8(*(const GAS v4u*)(kp + 128), hi);
            { const f32x4 c0 = *(const GAS f32x4*)(COS + t * 128 + d0), c1 = *(const GAS f32x4*)(COS + t * 128 + d0 + 4), s0 = *(const GAS f32x4*)(SIN + t * 128 + d0), s1 = *(const GAS f32x4*)(SIN + t * 128 + d0 + 4);
              cs[0] = c0.x; cs[1] = c0.y; cs[2] = c0.z; cs[3] = c0.w; cs[4] = c1.x; cs[5] = c1.y; cs[6] = c1.z; cs[7] = c1.w;
              sn[0] = s0.x; sn[1] = s0.y; sn[2] = s0.z; sn[3] = s0.w; sn[4] = s1.x; sn[5] = s1.y; sn[6] = s1.z; sn[7] = s1.w; }
            float nl[8], nh[8];
#pragma unroll
            for (int i = 0; i < 8; ++i) { nl[i] = (lo[i] * cs[i] - hi[i] * sn[i]) * 0.0625f; nh[i] = (lo[i] * sn[i] + hi[i] * cs[i]) * 0.0625f; }
            if constexpr (!NOSTORE) { *(GAS v4u*)kp = pack8(nl); *(GAS v4u*)(kp + 128) = pack8(nh); }
            const float dec = __builtin_amdgcn_exp2f((float)(255 - j) * lg);
#pragma unroll
            for (int i = 0; i < 8; ++i) { *(LAS bf16*)(Tl + tr_off(d0 + i, j)) = (bf16)f2bf(nl[i] * dec); *(LAS bf16*)(Tl + tr_off(128 + d0 + i, j)) = (bf16)f2bf(nh[i] * dec); }
        }
        LDS_WAIT(); __syncthreads();
#pragma unroll 4
        for (int n = 0; n < 16; ++n) { const int id = F.tid + 512 * n, d = id >> 5, chp = id & 31, jl = (chp ^ (d >> 3)) & 31;
            const v4u tv = *(const LAS v4u*)(Tl + d * 512 + chp * 16); if constexpr (!NOSTORE) *(GAS v4u*)(KT + (size_t)item * 65536 + d * 256 + jl * 8) = tv; else if (tv.x == 0x12345678u && tv.y == 0x9abcdef0u) *(GAS v4u*)(KT + (size_t)item * 65536 + d * 256 + jl * 8) = tv; }
        LDS_WAIT(); __syncthreads();
#pragma unroll 4
        for (int step = 0; step < 8; ++step) {
            const int j = step * 32 + trow; const size_t t = (size_t)c * 256 + j;
            const bf16* vp = RV + t * 2048 + h * 256 + d0;
            const v4u a = *(const GAS v4u*)vp, b = *(const GAS v4u*)(vp + 128);
            const unsigned aw[4] = {a.x, a.y, a.z, a.w}, bw[4] = {b.x, b.y, b.z, b.w};
#pragma unroll
            for (int i = 0; i < 8; ++i) { *(LAS bf16*)(Tl + tr_off(d0 + i, j)) = (bf16)((i & 1) ? (aw[i >> 1] >> 16) : (aw[i >> 1] & 0xffffu)); *(LAS bf16*)(Tl + tr_off(128 + d0 + i, j)) = (bf16)((i & 1) ? (bw[i >> 1] >> 16) : (bw[i >> 1] & 0xffffu)); }
        }
        LDS_WAIT(); __syncthreads();
#pragma unroll 4
        for (int n = 0; n < 16; ++n) { const int id = F.tid + 512 * n, d = id >> 5, chp = id & 31, jl = (chp ^ (d >> 3)) & 31;
            const v4u tv = *(const LAS v4u*)(Tl + d * 512 + chp * 16); if constexpr (!NOSTORE) *(GAS v4u*)(VS + (size_t)item * 131072 + d * 512 + jl * 8) = tv; else if (tv.x == 0x12345678u && tv.y == 0x9abcdef0u) *(GAS v4u*)(VS + (size_t)item * 131072 + d * 512 + jl * 8) = tv; }
        LDS_WAIT(); __syncthreads();
#pragma unroll 2
        for (int step = 0; step < 8; ++step) {
            const int j = step * 32 + trow; const size_t t = (size_t)c * 256 + j;
            bf16* qp = RQ + t * 2048 + h * 256 + d0;
            float lo[8], hi[8], cs[8], sn[8];
            unpack8(*(const GAS v4u*)qp, lo); unpack8(*(const GAS v4u*)(qp + 128), hi);
            { const f32x4 c0 = *(const GAS f32x4*)(COS + t * 128 + d0), c1 = *(const GAS f32x4*)(COS + t * 128 + d0 + 4), s0 = *(const GAS f32x4*)(SIN + t * 128 + d0), s1 = *(const GAS f32x4*)(SIN + t * 128 + d0 + 4);
              cs[0] = c0.x; cs[1] = c0.y; cs[2] = c0.z; cs[3] = c0.w; cs[4] = c1.x; cs[5] = c1.y; cs[6] = c1.z; cs[7] = c1.w;
              sn[0] = s0.x; sn[1] = s0.y; sn[2] = s0.z; sn[3] = s0.w; sn[4] = s1.x; sn[5] = s1.y; sn[6] = s1.z; sn[7] = s1.w; }
            float nl[8], nh[8];
#pragma unroll
            for (int i = 0; i < 8; ++i) { nl[i] = lo[i] * cs[i] - hi[i] * sn[i]; nh[i] = lo[i] * sn[i] + hi[i] * cs[i]; }
            if constexpr (!NOSTORE) { *(GAS v4u*)qp = pack8(nl); *(GAS v4u*)(qp + 128) = pack8(nh); }
            const float dec = __builtin_amdgcn_exp2f((float)(j + 1) * lg);
#pragma unroll
            for (int i = 0; i < 8; ++i) { nl[i] *= dec; nh[i] *= dec; }
            bf16* pq = PQ + (size_t)item * 131072 + (size_t)j * 512 + 256 + d0;
            if constexpr (!NOSTORE) { *(GAS v4u*)pq = pack8(nl); *(GAS v4u*)(pq + 128) = pack8(nh); } else if (nl[0] == 1.2345e30f) { *(GAS v4u*)pq = pack8(nl); *(GAS v4u*)(pq + 128) = pack8(nh); }
        }
    }
    { const bf16* MK = (const bf16*)(ws + WS_PROJ) + PROJ_STRIDE; float* KM = (float*)(ws + TAB_KMEAN);
      const int ll = F.lane & 15, rg = F.lane >> 4;
      for (int it = F.gw; it < 512; it += F.NGW) { const int j = it >> 4, h = it & 15;
          float acc[8] = {0.f, 0.f, 0.f, 0.f, 0.f, 0.f, 0.f, 0.f};
#pragma unroll 8
          for (int i = 0; i < 64; ++i) { const int r = rg + 4 * i; float f[8]; unpack8(*(const GAS v4u*)(MK + (size_t)(j * 256 + r) * 2048 + h * 128 + ll * 8), f);
#pragma unroll
              for (int e = 0; e < 8; ++e) acc[e] += f[e]; }
#pragma unroll
          for (int e = 0; e < 8; ++e) { acc[e] += __shfl_xor(acc[e], 16); acc[e] += __shfl_xor(acc[e], 32); }
          if (rg == 0) { GAS f32x4* o = (GAS f32x4*)(KM + (size_t)(j * 16 + h) * 128 + ll * 8);
              o[0] = (f32x4){acc[0], acc[1], acc[2], acc[3]} * (1.f / 256.f); o[1] = (f32x4){acc[4], acc[5], acc[6], acc[7]} * (1.f / 256.f); } } }
}

template <bool NOSTORE> __device__ __forceinline__ void p3_gating(Frame& F, unsigned char* ws) {
    const bf16* MQ = (const bf16*)(ws + WS_PROJ); const float* KM = (const float*)(ws + TAB_KMEAN);
    unsigned* CNT = (unsigned*)(ws + WS_CTL) + CW_CNT; unsigned* LIST = (unsigned*)(ws + WS_LIST);
    LAS float* kml = (LAS float*)F.lds;
    for (int item = blockIdx.x; item < 256; item += F.G) {
        const int h = item >> 4, grp = item & 15;
        __syncthreads();
        for (int i = F.tid; i < 32 * 32; i += 512) { const int j = i >> 5, c4 = i & 31; *(LAS f32x4*)(kml + j * 128 + c4 * 4) = *(const GAS f32x4*)(KM + (size_t)(j * 16 + h) * 128 + c4 * 4); }
        LDS_WAIT(); __syncthreads();
        const int q = grp * 512 + F.wave * 64 + F.lane, cur = (grp * 512 + F.wave * 64) >> 8;
        float qv[128];
#pragma unroll
        for (int k = 0; k < 16; ++k) { float f[8]; unpack8(*(const GAS v4u*)(MQ + (size_t)q * 2048 + h * 128 + k * 8), f);
#pragma unroll
            for (int e = 0; e < 8; ++e) qv[k * 8 + e] = f[e]; }
        float v1 = -__builtin_inff(), v2 = v1, v3 = v1; int i1 = 0, i2 = 0, i3 = 0;
        for (int j = 0; j < cur; ++j) { float g0 = 0.f, g1 = 0.f;
#pragma unroll
            for (int k = 0; k < 32; ++k) { const f32x4 kk = *(const LAS f32x4*)(kml + j * 128 + k * 4); g0 += qv[4 * k] * kk.x; g1 += qv[4 * k + 1] * kk.y; g0 += qv[4 * k + 2] * kk.z; g1 += qv[4 * k + 3] * kk.w; }
            const float g = g0 + g1;
            if (g > v1) { v3 = v2; i3 = i2; v2 = v1; i2 = i1; v1 = g; i1 = j; } else if (g > v2) { v3 = v2; i3 = i2; v2 = g; i2 = j; } else if (g > v3) { v3 = g; i3 = j; } }
        int nsel = cur < 3 ? cur : 3;
        if constexpr (NOSTORE) { if (v1 + v2 + v3 != 1.2345e30f) nsel = 0; }
        for (int s = 0; s < nsel; ++s) { const int blk = s == 0 ? i1 : (s == 1 ? i2 : i3);
            unsigned long long rem = __ballot(1);
            while (rem) { const int leader = __builtin_ctzll(rem); const int b = __builtin_amdgcn_readlane(blk, leader);
                const unsigned long long mask = __ballot(blk == b); const int n = __builtin_popcountll(mask);
                unsigned basep = 0; if (F.lane == leader) basep = atomicAdd(&CNT[h * 32 + b], (unsigned)n);
                basep = __builtin_amdgcn_readlane(basep, leader);
                if (blk == b) { const unsigned pos = basep + (unsigned)__builtin_popcountll(mask & ((1ull << F.lane) - 1ull)); LIST[(size_t)(h * 32 + b) * 8192 + pos] = (unsigned)q | ((unsigned)s << 16); }
                rem &= ~mask; } }
    }
}

__device__ __forceinline__ void p4_scan(Frame& F, unsigned char* ws) {
    if (F.tid >= 256) return;
    const float* UT = (const float*)(ws + WS_UT); bf16* VS = (bf16*)(ws + WS_VS);
    for (int idx = blockIdx.x * 256 + F.tid; idx < 65536; idx += F.G * 256) { const int h = idx >> 13, e = (idx >> 5) & 255, dch = idx & 31;
        const float lg = __builtin_log2f(1.f - __builtin_exp2f(-5.f - (float)h)); const float gC = __builtin_amdgcn_exp2f(256.f * lg);
        f32x4 s0 = {0.f, 0.f, 0.f, 0.f}, s1 = s0;
#pragma unroll 8
        for (int c = 0; c < 32; ++c) { const size_t z = (size_t)h * 32 + c;
            v4u o; o.x = pk2(s0.x, s0.y); o.y = pk2(s0.z, s0.w); o.z = pk2(s1.x, s1.y); o.w = pk2(s1.z, s1.w);
            *(GAS v4u*)(VS + z * 131072 + (size_t)e * 512 + 256 + dch * 8) = o;
            const GAS f32x4* up = (const GAS f32x4*)(UT + z * 65536 + (size_t)e * 256 + dch * 8);
            s0 = s0 * gC + up[0]; s1 = s1 * gC + up[1]; } }
}

__device__ __forceinline__ unsigned off_b(unsigned row, unsigned ch) { return 256u * row + 16u * (ch ^ (((row & 3u) << 2) | ((row >> 2) & 3u))); }
__device__ __forceinline__ s16x4 vtr(const LAS unsigned char* p) { return __builtin_bit_cast(s16x4, __builtin_amdgcn_ds_read_tr16_b64_v4i16((LAS v4i16_t*)p)); }
__device__ __forceinline__ unsigned cvtpk(float lo, float hi) { unsigned r; asm volatile("v_cvt_pk_bf16_f32 %0, %1, %2" : "=v"(r) : "v"(lo), "v"(hi)); return r; }

struct MobaUnit { int h, kb, nrows, own; const unsigned* list; };
__device__ __forceinline__ MobaUnit moba_decode(const LAS int* pre, const unsigned* CNT, const unsigned* LIST, int NG, int u) {
    MobaUnit U;
    if (u < NG) { int lo = 0, hi = 511;
        while (lo < hi) { const int mid = (lo + hi + 1) >> 1; if (pre[mid] <= u) lo = mid; else hi = mid - 1; }
        const int p = lo, tile = u - pre[p]; const int cnt = (int)__hip_atomic_load(CNT + p, __ATOMIC_RELAXED, __HIP_MEMORY_SCOPE_AGENT);
        U.h = p >> 5; U.kb = p & 31; U.nrows = cnt - tile * 256 < 256 ? cnt - tile * 256 : 256; U.own = 0; U.list = LIST + (size_t)p * 8192 + tile * 256;
    } else { const int v = u - NG; U.h = v >> 5; U.kb = v & 31; U.nrows = 256; U.own = 1; U.list = LIST; }
    return U;
}
__device__ __forceinline__ void moba_stage(Frame& F, const bf16* MK, const bf16* MV, int h, int kb, int hf, LAS unsigned char* buf) {
#pragma unroll
    for (int n = 0; n < 4; ++n) { const int piece = F.wave + 8 * n, row = piece * 4 + (F.lane >> 4), ch = (F.lane & 15) ^ (((row & 3) << 2) | ((row >> 2) & 3));
        const size_t g = (size_t)(kb * 256 + hf * 128 + row) * 2048 + h * 128 + ch * 8;
        __builtin_amdgcn_global_load_lds((const unsigned*)(MK + g), (LAS unsigned*)(buf + piece * 1024), 16, 0, 0);
        __builtin_amdgcn_global_load_lds((const unsigned*)(MV + g), (LAS unsigned*)(buf + 32768 + piece * 1024), 16, 0, 0); }
}
__device__ __forceinline__ void moba_btab(Frame& F, const float* TB, int h, LAS float* bt) {
    if (F.tid < 384) bt[F.tid] = F.tid < 255 ? -__builtin_inff() : TB[h * 132 + (F.tid - 255)];
}

__device__ __forceinline__ void p4_moba(Frame& F, unsigned char* ws) {
    const unsigned* CNT = (const unsigned*)(ws + WS_CTL) + CW_CNT; const unsigned* LIST = (const unsigned*)(ws + WS_LIST);
    const bf16* MQ = (const bf16*)(ws + WS_PROJ); const bf16* MK = MQ + PROJ_STRIDE; const bf16* MV = MK + PROJ_STRIDE;
    bf16* PART = (bf16*)(ws + WS_PART); float* ML = (float*)(ws + WS_ML); const float* TB = (const float*)(ws + TAB_BIAS);
    LAS int* pre = (LAS int*)(F.lds + 140000);
    LAS float* btab0 = (LAS float*)(F.lds + 131072);
    const int lane = F.lane, r32 = lane & 31, hh = lane >> 5;
    __syncthreads();
    if (F.tid < 64) {
        int c8[8], s = 0;
#pragma unroll
        for (int k = 0; k < 8; ++k) { c8[k] = (int)((__hip_atomic_load(CNT + F.lane * 8 + k, __ATOMIC_RELAXED, __HIP_MEMORY_SCOPE_AGENT) + 255u) >> 8); s += c8[k]; }
        int inc = s;
#pragma unroll
        for (int o = 1; o < 64; o <<= 1) { const int t = __shfl_up(inc, o); if (F.lane >= o) inc += t; }
        int run = inc - s;
#pragma unroll
        for (int k = 0; k < 8; ++k) { pre[F.lane * 8 + k] = run; run += c8[k]; }
        if (F.lane == 63) pre[512] = run;
    }
    LDS_WAIT(); __syncthreads();
    const int NG = pre[512], NU = NG + 512;
    const int vcu = (F.G % 8 == 0) ? ((int)blockIdx.x % 8) * (F.G / 8) + (int)blockIdx.x / 8 : (int)blockIdx.x;
    if (vcu >= NU) return;
    const int nun = (NU - vcu + F.G - 1) / F.G;
    LAS int* utab = (LAS int*)(F.lds + 144000);
    if (F.tid < nun && F.tid < 32) { const MobaUnit T = moba_decode(pre, CNT, LIST, NG, vcu + F.tid * F.G);
        utab[F.tid * 5 + 0] = T.h; utab[F.tid * 5 + 1] = T.kb; utab[F.tid * 5 + 2] = T.nrows; utab[F.tid * 5 + 3] = T.own; utab[F.tid * 5 + 4] = (int)(T.list - LIST); }
    LDS_WAIT(); __syncthreads();
#define UTAB(k) MobaUnit{utab[(k) * 5 + 0], utab[(k) * 5 + 1], utab[(k) * 5 + 2], utab[(k) * 5 + 3], LIST + utab[(k) * 5 + 4]}
    unsigned kaddr[8];
#pragma unroll
    for (int s = 0; s < 8; ++s) kaddr[s] = off_b((unsigned)r32, (unsigned)(2 * s + hh));
    unsigned vaddr[4][2];
    { const unsigned blk = (lane >> 4) & 1, q4 = (lane & 15) >> 2, p = lane & 3;
#pragma unroll
      for (int c = 0; c < 4; ++c)
#pragma unroll
          for (int t = 0; t < 2; ++t) vaddr[c][t] = off_b(8u * t + 4u * hh + q4, 4u * c + 2u * blk + (p >> 1)) + 8u * (p & 1); }
    MobaUnit U = UTAB(0);
    moba_stage(F, MK, MV, U.h, U.kb, 0, F.lds);
    moba_btab(F, TB, U.h, btab0);
    const int rix = F.wave * 32 + r32;
    unsigned ent = (!U.own && rix < U.nrows) ? U.list[rix] : 8191u;
    int qpos_n = U.own ? U.kb * 256 + rix : (int)(ent & 0xffffu), slot_n = U.own ? 3 : (int)(ent >> 16);
    bf16x8 qn[8];
#pragma unroll
    for (int s = 0; s < 8; ++s) qn[s] = *(const GAS bf16x8*)(MQ + (size_t)qpos_n * 2048 + U.h * 128 + 16 * s + 8 * hh);
    MobaUnit Un = U;
    bf16x8 qf[8]; f32x16 o[4]; float m = -1e30f, l = 0.f; int qpos = 0, slot = 0; bool valid = false, far = false;
    for (int i = 0; i < nun; ++i) {
        const LAS float* btab = btab0 + (i & 1) * 384;
#pragma unroll
        for (int hf = 0; hf < 2; ++hf) {
            LAS unsigned char* buf = F.lds + hf * 65536;
            VM_WAIT(); LDS_WAIT(); __syncthreads();
            if (hf == 0) {
                valid = rix < U.nrows; qpos = qpos_n; slot = slot_n;
#pragma unroll
                for (int s = 0; s < 8; ++s) qf[s] = qn[s];
                if (i + 1 < nun) { Un = UTAB(i + 1); ent = (!Un.own && rix < Un.nrows) ? Un.list[rix] : 8191u; }
                moba_stage(F, MK, MV, U.h, U.kb, 1, F.lds + 65536);
                far = __all(qpos - (U.kb * 256 + 255) >= 113) != 0;
                m = -1e30f; l = 0.f;
#pragma unroll
                for (int c = 0; c < 4; ++c)
#pragma unroll
                    for (int r = 0; r < 16; ++r) o[c][r] = 0.f;
            } else if (i + 1 < nun) {
                qpos_n = Un.own ? Un.kb * 256 + rix : (int)(ent & 0xffffu); slot_n = Un.own ? 3 : (int)(ent >> 16);
#pragma unroll
                for (int s = 0; s < 8; ++s) qn[s] = *(const GAS bf16x8*)(MQ + (size_t)qpos_n * 2048 + Un.h * 128 + 16 * s + 8 * hh);
                moba_stage(F, MK, MV, Un.h, Un.kb, 0, F.lds);
                moba_btab(F, TB, Un.h, btab0 + ((i + 1) & 1) * 384);
            }
            const int kbase = U.kb * 256;
#pragma unroll
            for (int lc = 0; lc < 2; ++lc) {
                const int kc = 2 * hf + lc;
                if (U.own && kc > (F.wave >> 1)) continue;
                f32x16 p0, p1;
#pragma unroll
                for (int r = 0; r < 16; ++r) { p0[r] = 0.f; p1[r] = 0.f; }
                const LAS unsigned char* Kc = buf + lc * 16384;
                { bf16x8 ka[8], kb2[8];
#pragma unroll
                  for (int s = 0; s < 8; ++s) ka[s] = *(const LAS bf16x8*)(Kc + kaddr[s]);
#pragma unroll
                  for (int s = 0; s < 8; ++s) kb2[s] = *(const LAS bf16x8*)(Kc + 8192 + kaddr[s]);
#pragma unroll
                  for (int s = 0; s < 8; ++s) p0 = __builtin_amdgcn_mfma_f32_32x32x16_bf16(ka[s], qf[s], p0, 0, 0, 0);
#pragma unroll
                  for (int s = 0; s < 8; ++s) p1 = __builtin_amdgcn_mfma_f32_32x32x16_bf16(kb2[s], qf[s], p1, 0, 0, 0);
                  __builtin_amdgcn_sched_group_barrier(0x100, 8, 0);
#pragma unroll
                  for (int q = 0; q < 8; ++q) { __builtin_amdgcn_sched_group_barrier(0x008, 1, 0); __builtin_amdgcn_sched_group_barrier(0x100, 1, 0); }
                  __builtin_amdgcn_sched_group_barrier(0x008, 8, 0); }
                if (!far) {
                    asm volatile("" ::: "memory");
                    const int dq = qpos - (kbase + kc * 64 + 4 * hh) + 255;
#pragma unroll
                    for (int r = 0; r < 16; ++r) { const int cr = (r & 3) + 8 * (r >> 2); int i0 = dq - cr, i1 = i0 - 32;
                        i0 = i0 > 383 ? 383 : i0; i1 = i1 > 383 ? 383 : i1; i0 = i0 < 0 ? 0 : i0; i1 = i1 < 0 ? 0 : i1;
                        p0[r] += btab[i0]; p1[r] += btab[i1]; } }
                float pmax = p0[0];
#pragma unroll
                for (int r = 1; r < 16; ++r) pmax = fmaxf(pmax, p0[r]);
#pragma unroll
                for (int r = 0; r < 16; ++r) pmax = fmaxf(pmax, p1[r]);
                pmax = fmaxf(pmax, __shfl_xor(pmax, 32));
                if (!__all(pmax - m <= 8.f)) { const float mn = fmaxf(m, pmax); const float alpha = __builtin_amdgcn_exp2f(m - mn); m = mn; l *= alpha;
#pragma unroll
                    for (int c = 0; c < 4; ++c)
#pragma unroll
                        for (int r = 0; r < 16; ++r) o[c][r] *= alpha; }
                float ls = 0.f;
#pragma unroll
                for (int r = 0; r < 16; ++r) { p0[r] = __builtin_amdgcn_exp2f(p0[r] - m); p1[r] = __builtin_amdgcn_exp2f(p1[r] - m); ls += p0[r] + p1[r]; }
                l += ls;
                const LAS unsigned char* Vc = buf + 32768 + lc * 16384;
                { v4u pw[4];
                  pw[0].x = cvtpk(p0[0], p0[1]); pw[0].y = cvtpk(p0[2], p0[3]); pw[0].z = cvtpk(p0[4], p0[5]); pw[0].w = cvtpk(p0[6], p0[7]);
                  pw[1].x = cvtpk(p0[8], p0[9]); pw[1].y = cvtpk(p0[10], p0[11]); pw[1].z = cvtpk(p0[12], p0[13]); pw[1].w = cvtpk(p0[14], p0[15]);
                  pw[2].x = cvtpk(p1[0], p1[1]); pw[2].y = cvtpk(p1[2], p1[3]); pw[2].z = cvtpk(p1[4], p1[5]); pw[2].w = cvtpk(p1[6], p1[7]);
                  pw[3].x = cvtpk(p1[8], p1[9]); pw[3].y = cvtpk(p1[10], p1[11]); pw[3].z = cvtpk(p1[12], p1[13]); pw[3].w = cvtpk(p1[14], p1[15]);
#pragma unroll
                  for (int ss = 0; ss < 4; ++ss) {
                      const bf16x8 pb = __builtin_bit_cast(bf16x8, pw[ss]);
#pragma unroll
                      for (int c = 0; c < 4; ++c) { const s16x4 lo = vtr(Vc + ss * 4096 + vaddr[c][0]), hi = vtr(Vc + ss * 4096 + vaddr[c][1]);
                          const bf16x8 va = __builtin_shufflevector(lo, hi, 0, 1, 2, 3, 4, 5, 6, 7);
                          o[c] = __builtin_amdgcn_mfma_f32_32x32x16_bf16(va, pb, o[c], 0, 0, 0); } }
                  __builtin_amdgcn_sched_group_barrier(0x100, 8, 0);
#pragma unroll
                  for (int q = 0; q < 12; ++q) { __builtin_amdgcn_sched_group_barrier(0x008, 1, 0); __builtin_amdgcn_sched_group_barrier(0x100, 2, 0); }
                  __builtin_amdgcn_sched_group_barrier(0x008, 4, 0); }
            }
            if (hf == 1) {
                l += __shfl_xor(l, 32);
                if (far) m += btab[383];
                if (valid) {
                    const float il = 1.f / l; const size_t pbase = (((size_t)qpos * 16 + U.h) * 4 + slot);
                    bf16* po = PART + pbase * 128;
#pragma unroll
                    for (int c = 0; c < 4; ++c)
#pragma unroll
                        for (int g = 0; g < 4; ++g) { v2u w; w.x = pk2(o[c][4 * g] * il, o[c][4 * g + 1] * il); w.y = pk2(o[c][4 * g + 2] * il, o[c][4 * g + 3] * il);
                            *(GAS v2u*)(po + 32 * c + 8 * g + 4 * hh) = w; }
                    if (hh == 0) *(GAS f32x2*)(ML + pbase * 2) = (f32x2){m, l};
                }
                U = Un;
            }
        }
    }
#undef UTAB
}

__device__ __forceinline__ void p5_combine(Frame& F, unsigned char* ws) {
    const bf16* PART = (const bf16*)(ws + WS_PART); const float* ML = (const float*)(ws + WS_ML); bf16* MIX = (bf16*)(ws + WS_MIX);
    const int l16 = F.lane & 15, sub = F.lane >> 4;
    for (int pi0 = F.gw * 4 + sub; pi0 < T_ * 16; pi0 += F.NGW * 8) {
        f32x2 ml[2][4]; v4u pv[2][4]; int nv[2];
#pragma unroll
        for (int u = 0; u < 2; ++u) { const int pi = pi0 + u * F.NGW * 4; const int q = pi >> 4; nv[u] = (q >> 8) < 3 ? (q >> 8) : 3; const size_t pb = (size_t)pi * 4;
#pragma unroll
            for (int s = 0; s < 4; ++s) { const bool on = pi < T_ * 16 && ((s == 3) || (s < nv[u]));
                ml[u][s] = on ? *(const GAS f32x2*)(ML + (pb + s) * 2) : (f32x2){-1e30f, 0.f};
                pv[u][s] = on ? *(const GAS v4u*)(PART + (pb + s) * 128 + l16 * 8) : (v4u){0u, 0u, 0u, 0u}; } }
#pragma unroll
        for (int u = 0; u < 2; ++u) { const int pi = pi0 + u * F.NGW * 4; if (pi >= T_ * 16) continue; const int q = pi >> 4, h = pi & 15;
            float M = fmaxf(fmaxf(ml[u][0].x, ml[u][1].x), fmaxf(ml[u][2].x, ml[u][3].x));
            float acc[8] = {0.f, 0.f, 0.f, 0.f, 0.f, 0.f, 0.f, 0.f}; float W = 0.f;
#pragma unroll
            for (int s = 0; s < 4; ++s) { const float w = __builtin_amdgcn_exp2f(ml[u][s].x - M) * ml[u][s].y; W += w; float f[8]; unpack8(pv[u][s], f);
#pragma unroll
                for (int e = 0; e < 8; ++e) acc[e] += w * f[e]; }
            const float iw = 1.f / W;
#pragma unroll
            for (int e = 0; e < 8; ++e) acc[e] *= iw;
            *(GAS v4u*)(MIX + (size_t)q * 4096 + h * 128 + l16 * 8) = pack8(acc); } }
}

__device__ __forceinline__ unsigned f2ord(float f) { const unsigned u = __builtin_bit_cast(unsigned, f); return (u & 0x80000000u) ? ~u : (u | 0x80000000u); }
__device__ __forceinline__ float ord2f(unsigned o) { return __builtin_bit_cast(float, (o & 0x80000000u) ? (o ^ 0x80000000u) : ~o); }
#define CEX(a, b) do { const unsigned _hi = (a) > (b) ? (a) : (b); const unsigned _lo = (a) > (b) ? (b) : (a); (a) = _hi; (b) = _lo; } while (0)
__device__ __forceinline__ void bitonic_merge16(unsigned (&a)[16]) {
#pragma unroll
    for (int j = 8; j > 0; j >>= 1)
#pragma unroll
        for (int i = 0; i < 16; ++i) if ((i & j) == 0) CEX(a[i], a[i | j]);
}
__device__ __forceinline__ void sort16_desc(unsigned (&a)[16]) {
#pragma unroll
    for (int k = 2; k <= 16; k <<= 1)
#pragma unroll
        for (int j = k >> 1; j > 0; j >>= 1)
#pragma unroll
            for (int i = 0; i < 16; ++i) { const int l = i ^ j; if (l > i) { if ((i & k) == 0 || k == 16) { CEX(a[i], a[l]); } else { CEX(a[l], a[i]); } } }
}
__device__ __forceinline__ void merge_top16(unsigned (&L)[16], const unsigned (&G)[16]) {
#pragma unroll
    for (int i = 0; i < 16; ++i) L[i] = L[i] > G[15 - i] ? L[i] : G[15 - i];
    bitonic_merge16(L);
}

template <int MODE> __device__ __forceinline__ void p9_peer_route(Frame& F, unsigned char* ws) {
    const bf16* PQP = (const bf16*)(ws + WS_PQP); const bf16* KEYS = (const bf16*)(ws + TAB_KEYS); bf16* GW = (bf16*)(ws + WS_GW); unsigned* BM = (unsigned*)(ws + WS_BM);
    LAS unsigned* LE = (LAS unsigned*)F.lds; LAS float* LG = (LAS float*)(F.lds + 8192);
    LAS unsigned* HVAL = (LAS unsigned*)(F.lds + 16384);
    LAS unsigned* HKEY = (LAS unsigned*)(F.lds + 81920);
    LAS unsigned* BMl = (LAS unsigned*)(F.lds + 98304);
    LAS unsigned* ABL = (LAS unsigned*)(F.lds + 102400);
    const int lane = F.lane, w = F.wave, tk = lane & 15, q = lane >> 4;
    for (int unit = blockIdx.x; unit < T_ / 16; unit += F.G) {
        const int t0 = unit * 16;
        __syncthreads();
        { const v4u z = {0u, 0u, 0u, 0u}, ff = {0xffffffffu, 0xffffffffu, 0xffffffffu, 0xffffffffu};
          for (int i = F.tid; i < 65536 / 16; i += 512) *(LAS v4u*)((LAS unsigned char*)HVAL + i * 16) = z;
          for (int i = F.tid; i < 16384 / 16; i += 512) *(LAS v4u*)((LAS unsigned char*)HKEY + i * 16) = ff;
          if (F.tid < 256) *(LAS v4u*)((LAS unsigned char*)BMl + F.tid * 16) = z; }
        unsigned AB[2][16];
#pragma unroll
        for (int c = 0; c < 2; ++c) {
            bf16x8 af[4];
#pragma unroll
            for (int ks = 0; ks < 4; ++ks) af[ks] = *(const GAS bf16x8*)(PQP + (size_t)(t0 + tk) * 2048 + w * 256 + c * 128 + 32 * ks + 8 * q);
            unsigned kk[2][16];
#pragma unroll
            for (int nt = 0; nt < 8; ++nt) { f32x4 acc = {0.f, 0.f, 0.f, 0.f};
#pragma unroll
                for (int ks = 0; ks < 4; ++ks) { const bf16x8 kf = *(const GAS bf16x8*)(KEYS + (size_t)((w * 2 + c) * 128 + 16 * nt + tk) * 128 + 32 * ks + 8 * q);
                    acc = __builtin_amdgcn_mfma_f32_16x16x32_bf16(kf, af[ks], acc, 0, 0, 0); }
#pragma unroll
                for (int r = 0; r < 4; ++r) kk[nt >> 2][(nt & 3) * 4 + r] = (f2ord(acc[r]) & 0xffffff80u) | (unsigned)(16 * nt + 4 * q + r); }
            sort16_desc(kk[0]); sort16_desc(kk[1]); merge_top16(kk[0], kk[1]);
            unsigned G[16];
#pragma unroll
            for (int i = 0; i < 16; ++i) G[i] = (unsigned)__shfl_xor((int)kk[0][i], 16);
            merge_top16(kk[0], G);
#pragma unroll
            for (int i = 0; i < 16; ++i) G[i] = (unsigned)__shfl_xor((int)kk[0][i], 32);
            merge_top16(kk[0], G);
#pragma unroll
            for (int i = 0; i < 16; ++i) AB[c][i] = kk[0][i];
        }
        if (q == 0) {
#pragma unroll
            for (int i = 0; i < 4; ++i) { *(LAS v4u*)(ABL + (w * 16 + tk) * 32 + 4 * i) = (v4u){AB[0][4 * i], AB[0][4 * i + 1], AB[0][4 * i + 2], AB[0][4 * i + 3]};
                *(LAS v4u*)(ABL + (w * 16 + tk) * 32 + 16 + 4 * i) = (v4u){AB[1][4 * i], AB[1][4 * i + 1], AB[1][4 * i + 2], AB[1][4 * i + 3]}; } }
        if constexpr (MODE != 3) {
        unsigned M[16];
#pragma unroll
        for (int i = 0; i < 16; ++i) M[i] = 0u;
        { float av[16], bv[16];
#pragma unroll
          for (int i = 0; i < 16; ++i) { av[i] = ord2f(AB[0][i] & 0xffffff80u); bv[i] = ord2f(AB[1][i] & 0xffffff80u); }
          unsigned cd[16]; int nc = 0;
#pragma unroll
          for (int i = 0; i < 16; ++i)
#pragma unroll
              for (int j = 0; j < 16; ++j) if ((i + 1) * (j + 1) <= 16) {
                  cd[nc & 15] = (f2ord(av[i] + bv[j]) & 0xffffff00u) | (unsigned)(i * 16 + j); ++nc;
                  if ((nc & 15) == 0) { sort16_desc(cd); if (nc == 16) {
#pragma unroll
                      for (int x = 0; x < 16; ++x) M[x] = cd[x]; } else merge_top16(M, cd); } }
#pragma unroll
          for (int x = 2; x < 16; ++x) cd[x] = 0u;
          sort16_desc(cd); merge_top16(M, cd); }
        LDS_WAIT(); __builtin_amdgcn_wave_barrier();
        { float sc[16]; float mx = -__builtin_inff();
#pragma unroll
          for (int k = 0; k < 16; ++k) { sc[k] = ord2f(M[k] & 0xffffff00u); mx = fmaxf(mx, sc[k]); }
          float sum = 0.f;
#pragma unroll
          for (int k = 0; k < 16; ++k) { sc[k] = __builtin_amdgcn_exp2f((sc[k] - mx) * LOG2E); sum += sc[k]; }
          const float is = 1.f / sum;
#pragma unroll
          for (int k = 0; k < 16; ++k) if ((k >> 2) == q) { const unsigned id = M[k] & 255u, i = id >> 4, j = id & 15u;
              const unsigned ea = ABL[(w * 16 + tk) * 32 + i] & 127u, eb = ABL[(w * 16 + tk) * 32 + 16 + j] & 127u;
              LE[tk * 128 + w * 16 + k] = ea * 128u + eb; LG[tk * 128 + w * 16 + k] = sc[k] * is; } }
        } else { if (AB[0][0] == 0x12345u && AB[1][5] == 7u) LE[tk] = AB[0][3]; }
        LDS_WAIT(); __syncthreads();
        if constexpr (MODE <= 1) {
#pragma unroll
        for (int k = 0; k < 4; ++k) { const int pidx = F.tid + 512 * k, tok = pidx >> 7; const unsigned e = LE[pidx]; const float g = LG[pidx]; const unsigned ch = e >> 3;
            unsigned hs = (ch * 0x9E3779B1u) >> 24;
            for (;;) { unsigned expect = 0xffffffffu;
                const bool ok = __hip_atomic_compare_exchange_strong(HKEY + tok * 256 + hs, &expect, ch, __ATOMIC_RELAXED, __ATOMIC_RELAXED, __HIP_MEMORY_SCOPE_WORKGROUP);
                if (ok || expect == ch) break; hs = (hs + 1u) & 255u; }
            const unsigned gb = f2bf(g);
            __builtin_amdgcn_ds_atomic_fadd_v2bf16((LAS s16x2*)(HVAL + ((tok * 256 + hs) * 4 + ((e & 7u) >> 1))), __builtin_bit_cast(s16x2, (e & 1u) ? (gb << 16) : gb)); }
        LDS_WAIT(); __syncthreads();
#pragma unroll
        for (int k = 0; k < 8; ++k) { const int sidx = F.tid + 512 * k, tok = sidx >> 8; const unsigned ch = HKEY[sidx];
            if (ch != 0xffffffffu) {
                if constexpr (MODE == 0) *(GAS v4u*)(GW + (size_t)(t0 + tok) * 16384 + ch * 8) = *(const LAS v4u*)(HVAL + sidx * 4);
                __hip_atomic_fetch_or(BMl + tok * 64 + (ch >> 5), 1u << (ch & 31u), __ATOMIC_RELAXED, __HIP_MEMORY_SCOPE_WORKGROUP); } }
        LDS_WAIT(); __syncthreads();
        }
        if constexpr (MODE == 0)
        for (int i = F.tid; i < 1024; i += 512) BM[(size_t)t0 * 64 + i] = BMl[i];
    }
}

__device__ __forceinline__ void p12_final_norm(Frame& F, const Args& args) {
    for (int m = F.gw; m < T_; m += F.NGW) { float* row = args.out + (size_t)m * DM; const GAS f32x4* xr = (const GAS f32x4*)row + F.lane; const GAS f32x4* gr = (const GAS f32x4*)args.in[10] + F.lane;
        f32x4 v[16]; float s = 0.f;
#pragma unroll
        for (int j = 0; j < 16; ++j) { v[j] = xr[64 * j]; s += (v[j].x * v[j].x + v[j].y * v[j].y) + (v[j].z * v[j].z + v[j].w * v[j].w); }
        const float rstd = 1.f / sqrtf(wave_sum(s) * (1.f / DM) + NORM_EPS);
        GAS f32x4* o = (GAS f32x4*)row + F.lane;
#pragma unroll
        for (int j = 0; j < 16; ++j) o[64 * j] = v[j] * rstd * gr[64 * j]; }
}

constexpr int NPH = 13;
__global__ void __launch_bounds__(512, 2) fwd(Args args) {
    extern __shared__ __attribute__((aligned(16))) unsigned char lds_raw[];
    Frame F;
    F.lds = (LAS unsigned char*)lds_raw;
    F.tid = threadIdx.x; F.lane = F.tid & 63; F.wave = __builtin_amdgcn_readfirstlane(F.tid >> 6);
    F.G = gridDim.x; F.gw = blockIdx.x * 8 + F.wave; F.NGW = F.G * 8;
    unsigned char* ws = args.ws;
    volatile LAS unsigned* MISC = (volatile LAS unsigned*)(F.lds + MISC_OFF);
    for (int u = F.tid; u < (LDS_BYTES - LDSCTL_OFF) / 4; u += 512) ((LAS unsigned*)(F.lds + LDSCTL_OFF))[u] = 0u;
    __syncthreads();
    XcdBarrier bar = xcd_barrier_post((unsigned*)(ws + WS_CTL) + CW_BAR, MISC + 8);
    const int lo = args.ph_lo, hi = args.ph_hi;
#ifndef PHMASK
#define PHMASK 0xffff
#endif
#define IN(k) (((PHMASK >> (k)) & 1) && lo <= (k) && (k) < hi)
#define SEAM(k) do { if (IN(k) && IN((k) + 1)) xcd_barrier(bar); } while (0)
#ifndef PHDUP
#define PHDUP 0
#endif
#define DUPQ(k) (((PHDUP >> (k)) & 1) != 0)
    bf16* XN = (bf16*)(ws + WS_XN); bf16* MIX = (bf16*)(ws + WS_MIX); float* H1 = (float*)(ws + WS_H1);

#define PHASE(k, ...) if (IN(k)) { { __VA_ARGS__ } if (DUPQ(k)) { xcd_barrier(bar); { __VA_ARGS__ } } } SEAM(k);
    PHASE(0, p0_prologue(F, args);)
    PHASE(1,
        { pg8::Gemm g{(const bf16*)(ws + WS_XN8), (const bf16*)(ws + WS_WIN8), DM / 2, DM / 2, DM / 2, 0, 0}; pg8::StaticOrder S; S.init(T_, 3 * MW, F.G, (int)blockIdx.x);
          pg8::EpiBf16<0> E{(bf16*)(ws + WS_PROJ), 2048, nullptr, 2048, PROJ_STRIDE, QSCALE, 1.f / (XN8_SCALE * WIN8_SCALE)};
          pg8::gemm_phase<pg8::EpiBf16<0>, pg8::StaticOrder, true, true, 1>(F.lds, g, S, E); }
        { pg8::Gemm g{XN, (const bf16*)(ws + WS_WINB), DM, DM, DM, 0, 0}; pg8::StaticOrder S; S.init(T_, INW - 3 * MW, F.G, (int)blockIdx.x);
          pg8::EpiBf16<0> E{(bf16*)(ws + WS_PROJ) + 3 * PROJ_STRIDE, 2048, nullptr, 2048, PROJ_STRIDE, 1.f, 1.f};
          pg8::gemm_phase<pg8::EpiBf16<0>, pg8::StaticOrder, true, true>(F.lds, g, S, E); })
    if (IN(2)) { p2_prep<false>(F, ws); if (DUPQ(2)) { xcd_barrier(bar); p2_prep<true>(F, ws); } } SEAM(2);
#ifndef P3SUB
#define P3SUB 7
#endif
#define P3_PGEMM { pg8::Gemm g{(const bf16*)(ws + WS_PROJ) + 3 * PROJ_STRIDE, (const bf16*)(ws + WS_PROJ) + 4 * PROJ_STRIDE, 2048, 2048, 256, 256, 256}; \
          pg8::HOrder S{F.G, (int)blockIdx.x}; pg8::EpiRetP E{(bf16*)(ws + WS_PQ)}; \
          pg8::gemm_phase<pg8::EpiRetP, pg8::HOrder, false, true>(F.lds, g, S, E); }
#define P3_UTGEMM { pg8::Gemm g{(const bf16*)(ws + WS_VS), (const bf16*)(ws + WS_KT), 512, 256, 256, 131072, 65536}; pg8::BatchOrder S{256, F.G, (int)blockIdx.x}; \
          pg8::EpiF32Z E{(float*)(ws + WS_UT)}; \
          pg8::gemm_phase<pg8::EpiF32Z, pg8::BatchOrder, false, true>(F.lds, g, S, E); }
    if (IN(3)) {
        P3_PGEMM P3_UTGEMM p3_gating<false>(F, ws);
        if (DUPQ(3)) { xcd_barrier(bar); if (P3SUB & 1) P3_PGEMM if (P3SUB & 2) P3_UTGEMM if (P3SUB & 4) p3_gating<true>(F, ws); }
    } SEAM(3);
#ifndef P4SUB
#define P4SUB 3
#endif
    if (IN(4)) { p4_scan(F, ws); p4_moba(F, ws); if (DUPQ(4)) { xcd_barrier(bar); if (P4SUB & 1) p4_scan(F, ws); if (P4SUB & 2) p4_moba(F, ws); } } SEAM(4);
    PHASE(5,
        { pg8::Gemm g{(const bf16*)(ws + WS_PQ), (const bf16*)(ws + WS_VS), 512, 512, 512, 131072, 131072}; pg8::EpiRetOut E{(const bf16*)(ws + WS_PROJ) + 6 * PROJ_STRIDE, MIX};
          pg8::OneOrder O{(int)blockIdx.x};
          pg8::gemm_phase<pg8::EpiRetOut, pg8::OneOrder, false, true>(F.lds, g, O, E); __syncthreads(); }
        p5_combine(F, ws);)
    PHASE(6,
        pg8::Gemm g{MIX, (const bf16*)(ws + WS_WOUT_T), DM, DM, DM, 0, 0}; pg8::StaticOrder S; S.init(T_, DM, F.G, (int)blockIdx.x);
        pg8::EpiResF32 E{args.in[0], H1, DM, 1.f};
        pg8::gemm_phase<pg8::EpiResF32, pg8::StaticOrder, true, true>(F.lds, g, S, E);)
    PHASE(7, for (int m = F.gw; m < T_; m += F.NGW) rms_row_to_bf16<1>(F.lane, H1 + (size_t)m * DM, args.in[5], XN + (size_t)m * DM, ws + WS_TN8 + (size_t)m * DM);)
    PHASE(8,
        pg8::Gemm g{XN, (const bf16*)(ws + WS_WQ_T), DM, DM, DM, 0, 0}; pg8::StaticOrder S; S.init(T_, 2048, F.G, (int)blockIdx.x);
        pg8::EpiBf16<0> E{(bf16*)(ws + WS_PQP), 2048, nullptr, 0, 0, 1.f, 1.f};
        pg8::gemm_phase<pg8::EpiBf16<0>, pg8::StaticOrder, true, true>(F.lds, g, S, E);)
#ifndef P9MODE
#define P9MODE 0
#endif
    if (IN(9)) { p9_peer_route<0>(F, ws); if (DUPQ(9)) { xcd_barrier(bar); p9_peer_route<(P9MODE ? P9MODE : 1)>(F, ws); } } SEAM(9);
#ifndef P10MODE
#define P10MODE 1
#endif
    if (IN(10)) {
        { pg8::Gemm g{(const bf16*)(ws + WS_TN8), (const bf16*)(ws + WS_U8), DM / 2, DM / 2, DM / 2, 0, 0}; pg8::StaticOrder S; S.init(T_, NEXP, F.G, (int)blockIdx.x);
          pg8::EpiPeerW8<0> E{(const bf16*)(ws + WS_GW), (const unsigned*)(ws + WS_BM), ws + WS_W8, 1.f / (TN8_SCALE * U8_SCALE), W8_SCALE};
          pg8::gemm_phase<pg8::EpiPeerW8<0>, pg8::StaticOrder, true, true, 1>(F.lds, g, S, E); }
        if (DUPQ(10)) { xcd_barrier(bar);
          pg8::Gemm g{(const bf16*)(ws + WS_TN8), (const bf16*)(ws + WS_U8), DM / 2, DM / 2, DM / 2, 0, 0}; pg8::StaticOrder S; S.init(T_, NEXP, F.G, (int)blockIdx.x);
          pg8::EpiPeerW8<P10MODE> E{(const bf16*)(ws + WS_GW), (const unsigned*)(ws + WS_BM), ws + WS_GW, 1.f / (TN8_SCALE * U8_SCALE), W8_SCALE};
          pg8::gemm_phase<pg8::EpiPeerW8<P10MODE>, pg8::StaticOrder, true, true, 1>(F.lds, g, S, E); }
    } SEAM(10);
    PHASE(11,
        pg8::Gemm g{(const bf16*)(ws + WS_W8), (const bf16*)(ws + WS_V8T), NEXP / 2, NEXP / 2, NEXP / 2, 0, 0}; pg8::StaticOrder S; S.init(T_, DM, F.G, (int)blockIdx.x);
        pg8::EpiResF32 E{H1, args.out, DM, 1.f / (W8_SCALE * V8_SCALE)};
        pg8::gemm_phase<pg8::EpiResF32, pg8::StaticOrder, true, true, 1>(F.lds, g, S, E);)
#ifdef F6PROBE
    if (IN(11)) { xcd_barrier(bar);
        { pg8::Gemm g{(const bf16*)(ws + WS_W8), (const bf16*)(ws + WS_V8T), NEXP / 2, NEXP / 2, NEXP / 2, 0, 0}; pg8::StaticOrder S; S.init(T_, DM, F.G, (int)blockIdx.x);
          pg8::EpiResF32 E{H1, (float*)(ws + WS_GW), DM, 1.f};
          pg8::gemm_phase<pg8::EpiResF32, pg8::StaticOrder, true, true, 2>(F.lds, g, S, E); }
        xcd_barrier(bar); }
#endif
    if (IN(12)) p12_final_norm(F, args);
#undef PHASE
#undef IN
#undef SEAM
}

extern "C" void kernel_launch(void* const* d_in, const int* in_sizes, int n_in, void* d_out, int out_size, void* d_ws, size_t ws_size, hipStream_t stream) {
    static int grid = 0;
    if (grid == 0) {
        if (n_in != 11 || ws_size < WS_END) { fprintf(stderr, "kernel_launch: built for 11 inputs and >= %zu bytes of workspace; got n_in %d, ws %zu\n", (size_t)WS_END, n_in, ws_size); grid = -1; return; }
        int dev = 0, cus = 0, per_cu = 0;
        if (hipGetDevice(&dev) != hipSuccess || hipDeviceGetAttribute(&cus, hipDeviceAttributeMultiprocessorCount, dev) != hipSuccess) { grid = -1; return; }
        if (hipFuncSetAttribute((const void*)fwd, hipFuncAttributeMaxDynamicSharedMemorySize, LDS_BYTES) != hipSuccess) { fprintf(stderr, "kernel_launch: hipFuncSetAttribute failed\n"); grid = -1; return; }
        if (hipOccupancyMaxActiveBlocksPerMultiprocessor(&per_cu, (const void*)fwd, 512, LDS_BYTES) != hipSuccess || per_cu < 1) fprintf(stderr, "kernel_launch: occupancy query reports %d\n", per_cu);
        (void)hipGetLastError();
        grid = cus;
    }
    if (grid < 0) return;
    if (hipMemsetAsync((char*)d_ws + WS_CTL, 0, CTL_ZERO_BYTES, stream) != hipSuccess) return;
    Args a{};
    for (int i = 0; i < 11; ++i) a.in[i] = (const float*)d_in[i];
    a.out = (float*)d_out; a.ws = (unsigned char*)d_ws;
#if MK_ONE_LAUNCH
    a.ph_lo = 0; a.ph_hi = NPH;
    hipLaunchKernelGGL(fwd, dim3(grid), dim3(512), LDS_BYTES, stream, a);
#else
    for (int p = 0; p < NPH; ++p) { a.ph_lo = p; a.ph_hi = p + 1; hipLaunchKernelGGL(fwd, dim3(grid), dim3(512), LDS_BYTES, stream, a); }
#endif
}
```

```cpp
#include <hip/hip_runtime.h>
#include <cstdio>
#include <cstdint>

#ifndef MK_ONE_LAUNCH
#define MK_ONE_LAUNCH 1
#endif

namespace pg8 {
#define PG8_LAS __attribute__((address_space(3)))
typedef unsigned short bf16_t;
typedef short bf16x8 __attribute__((ext_vector_type(8)));
typedef float f32x4 __attribute__((ext_vector_type(4)));
typedef unsigned u32x4 __attribute__((ext_vector_type(4)));
constexpr int BM = 256, BK = 64, HALF = 128, HTB = HALF * BK * 2  , STAGE_BYTES = 8 * HTB, NXCD = 8, WGM = 8;

__host__ __device__ __forceinline__ int lds_byte(int r, int c) { const int st = (r >> 4) * 2 + (c >> 5), rr = r & 15, cc = c & 31, ob = rr * 64 + cc * 2; return st * 1024 + (ob ^ (((ob >> 9) & 1) << 5)); }
__host__ __device__ __forceinline__ void stage_rc(int b, int& R, int& C) { const int st = b / 1024, sb = b % 1024, swz = sb ^ (((sb >> 9) & 1) << 5); R = (st >> 1) * 16 + swz / 64; C = (st & 1) * 32 + (swz % 64) / 2; }
__host__ __device__ __forceinline__ int perm32(int rho) { const int n = rho >> 4, i = rho & 15; return 8 * (i >> 2) + 4 * n + (i & 3); }

typedef int v4i_t __attribute__((ext_vector_type(4)));
typedef int v8i_t __attribute__((ext_vector_type(8)));
typedef int v6i_t __attribute__((ext_vector_type(6)));
__device__ __forceinline__ v6i_t lo6(v8i_t v) { return __builtin_shufflevector(v, v, 0, 1, 2, 3, 4, 5); }
__device__ __forceinline__ v8i_t ld8(const PG8_LAS unsigned char* p) { const v4i_t a = *(const PG8_LAS v4i_t*)p, b = *(const PG8_LAS v4i_t*)(p + 1024); return __builtin_shufflevector(a, b, 0, 1, 2, 3, 4, 5, 6, 7); }
template <class...> struct pg8_void { typedef void type; };
template <class E, class = void> struct epi_state { struct type {}; static constexpr bool has = false; };
template <class E> struct epi_state<E, typename pg8_void<typename E::State>::type> { typedef typename E::State type; static constexpr bool has = true; };
struct Unit { int pm, pn, z; };
struct Gemm { const bf16_t* A; const bf16_t* Bt; int lda, ldb, K; long sAz, sBz; };

struct StaticOrder {
    int nM, nN, nwg, G, c;
    __host__ __device__ void init(int M, int N, int G_, int c_) { nM = M / BM; nN = N / BM; nwg = nM * nN; G = G_; c = c_; }
    __host__ __device__ bool next(int i, Unit& u) const {
        const long L = (long)i * G + c; if (L >= nwg) return false;
        int wgid = (int)L; { const int q = nwg / NXCD, r = nwg % NXCD, xcd = wgid % NXCD, off = wgid / NXCD; wgid = (xcd < r ? xcd * (q + 1) : r * (q + 1) + (xcd - r) * q) + off; }
        const int nig = WGM * nN, gid = wgid / nig, fm = gid * WGM, gsz = (nM - fm) < WGM ? (nM - fm) : WGM;
        u.pm = fm + ((wgid % nig) % gsz); u.pn = (wgid % nig) / gsz; u.z = 0; return true;
    }
    __device__ __forceinline__ void a_ready(const Unit&) const {}
    __device__ __forceinline__ void done(const Unit&) const {}
};

__device__ __forceinline__ unsigned cvt_pk_bf16(float lo, float hi) { unsigned r; asm volatile("v_cvt_pk_bf16_f32 %0, %1, %2" : "=v"(r) : "v"(lo), "v"(hi)); return r; }
typedef float f32x2 __attribute__((ext_vector_type(2)));
__device__ __forceinline__ f32x2 gelu_pk(f32x2 v) {
    const f32x2 av = __builtin_elementwise_abs(v), d = av * 0.2316418882f + 1.0f;
    f32x2 t; t.x = __builtin_amdgcn_rcpf(d.x); t.y = __builtin_amdgcn_rcpf(d.y);
    f32x2 q = t * 0.5307027145f + (-0.7265760135f); q = q * t + 0.7107068705f; q = q * t + (-0.142248368f); q = q * t + 0.127414796f; q = q * t;
    const f32x2 s = (v * v) * (-0.72134752044f);
    f32x2 e; e.x = __builtin_amdgcn_exp2f(s.x); e.y = __builtin_amdgcn_exp2f(s.y);
    const f32x2 m = v * (q * e), r = v - m;
    f32x2 o; o.x = v.x < 0.f ? m.x : r.x; o.y = v.y < 0.f ? m.y : r.y; return o;
}

template <int ACT  > struct EpiBf16 {
    static constexpr bool PERM = true, AFTER_DRAIN = false; static_assert(ACT == 0 || ACT == 1, "EpiBf16: ACT is 0 (none) or 1 (gelu_pk)");
    bf16_t* O; int ldc; const float* bias; int split_cols; size_t split_stride; float scale0, gs;
    __device__ __forceinline__ void operator()(const f32x4 (&acc)[2][2][4][2], const Unit& u, int wr, int wc, int fr, int fq) const {
        const int row0 = u.pm * BM + wr * 64 + fr; int colt = u.pn * BM; bf16_t* base = O;
        float sc = gs; if (split_cols) { const int t = colt / split_cols; base += (size_t)t * split_stride; colt -= t * split_cols; if (t == 0) sc = scale0 * gs; }
        const int col0 = colt + wc * 32 + 8 * fq, bcol0 = u.pn * BM + wc * 32 + 8 * fq;
        f32x4 bv[2][2];
#pragma unroll
        for (int bj = 0; bj < 2; ++bj)
#pragma unroll
            for (int n = 0; n < 2; ++n) bv[bj][n] = bias ? *(const f32x4*)(bias + bcol0 + bj * HALF + 4 * n) : (f32x4){0.f, 0.f, 0.f, 0.f};
#pragma unroll
        for (int ai = 0; ai < 2; ++ai)
#pragma unroll
            for (int m = 0; m < 4; ++m) { bf16_t* rowp = base + (size_t)(row0 + ai * HALF + m * 16) * ldc + col0;
#pragma unroll
                for (int bj = 0; bj < 2; ++bj) { f32x4 v0 = acc[ai][bj][m][0] + bv[bj][0], v1 = acc[ai][bj][m][1] + bv[bj][1];
                    if (ACT == 1) { f32x2 a = gelu_pk((f32x2){v0[0], v0[1]}), b = gelu_pk((f32x2){v0[2], v0[3]}), c = gelu_pk((f32x2){v1[0], v1[1]}), d = gelu_pk((f32x2){v1[2], v1[3]});
                        v0 = (f32x4){a.x, a.y, b.x, b.y}; v1 = (f32x4){c.x, c.y, d.x, d.y}; }
                    v0 = v0 * sc; v1 = v1 * sc; u32x4 w; w.x = cvt_pk_bf16(v0[0], v0[1]); w.y = cvt_pk_bf16(v0[2], v0[3]); w.z = cvt_pk_bf16(v1[0], v1[1]); w.w = cvt_pk_bf16(v1[2], v1[3]);
                    *(u32x4*)(rowp + bj * HALF) = w; } }
    }
};

template <class Epi, class Sched, bool ALIGN_EPI = false, bool SP2 = false, int F8 = 0>
__device__ __forceinline__ void gemm_phase(PG8_LAS unsigned char* lds, const Gemm g, const Sched& S, const Epi& E) {
    const int tid = threadIdx.x, wid = __builtin_amdgcn_readfirstlane(tid >> 6), lane = tid & 63, wr = wid >> 2, wc = wid & 3, fr = lane & 15, fq = lane >> 4;
    const int K = g.K, nt = K / BK;
    unsigned voffA[2], voffB[2];
#pragma unroll
    for (int i = 0; i < 2; ++i) { int R, C; stage_rc(tid * 16 + i * 8192, R, C); const int Rb = Epi::PERM ? ((R & ~31) + perm32(R & 31)) : R;
        voffA[i] = (unsigned)(R * g.lda + C) * 2u; voffB[i] = (unsigned)(Rb * g.ldb + C) * 2u; }
    const size_t kstep = (size_t)(BK * 2);
    const size_t hstepA = (size_t)HALF * g.lda * 2, hstepB = (size_t)HALF * g.ldb * 2;
    const unsigned ldsw = (unsigned)wid * 1024u;
    const int aoff = lds_byte(wr * 64 + fr, fq * 8), boff = lds_byte(wc * 32 + fr, fq * 8);
#define PG8_SA(b, h) (((b) * 2 + (h)) * HTB)
#define PG8_SB(b, h) ((4 + (b) * 2 + (h)) * HTB)
#define PG8_STAGE(bufoff, gbase, voff) do { _Pragma("unroll") for (int _i = 0; _i < 2; ++_i) \
        __builtin_amdgcn_global_load_lds((const unsigned*)((const char*)(gbase) + (voff)[_i]), (PG8_LAS unsigned*)(lds + (bufoff) + ldsw + _i * 8192), 16, 0, 0); } while (0)
#define PG8_LDA(dst, b, h) do { if constexpr (F8) { _Pragma("unroll") for (int m = 0; m < 4; ++m) dst##8[m] = ld8(lds + PG8_SA(b, h) + aoff + m * 2048); } else { _Pragma("unroll") for (int m = 0; m < 4; ++m) _Pragma("unroll") for (int k = 0; k < 2; ++k) dst[m][k] = *(const PG8_LAS bf16x8*)(lds + PG8_SA(b, h) + aoff + m * 2048 + k * 1024); } } while (0)
#define PG8_LDB(dst, b, h) do { if constexpr (F8) { _Pragma("unroll") for (int n = 0; n < 2; ++n) dst##8[n] = ld8(lds + PG8_SB(b, h) + boff + n * 2048); } else { _Pragma("unroll") for (int n = 0; n < 2; ++n) _Pragma("unroll") for (int k = 0; k < 2; ++k) dst[n][k] = *(const PG8_LAS bf16x8*)(lds + PG8_SB(b, h) + boff + n * 2048 + k * 1024); } } while (0)
#define PG8_MMA(ai, bj, At, Bt) do { __builtin_amdgcn_s_setprio(1); if constexpr (F8 == 2) { _Pragma("unroll") for (int m = 0; m < 4; ++m) _Pragma("unroll") for (int n = 0; n < 2; ++n) \
        asm volatile("s_nop 1\n\tv_mfma_scale_f32_16x16x128_f8f6f4 %0, %1, %2, %0, %3, %4 op_sel_hi:[0,0,0] cbsz:2 blgp:2" : "+v"(acc[ai][bj][m][n]) : "v"(lo6(Bt##8[n])), "v"(lo6(At##8[m])), "v"(Bt##8[n][6]), "v"(At##8[m][6])); } else if constexpr (F8 == 1) { _Pragma("unroll") for (int m = 0; m < 4; ++m) _Pragma("unroll") for (int n = 0; n < 2; ++n) \
        asm volatile("s_nop 1\n\tv_mfma_scale_f32_16x16x128_f8f6f4 %0, %1, %2, %0, %3, %3 op_sel_hi:[0,0,0]" : "+v"(acc[ai][bj][m][n]) : "v"(Bt##8[n]), "v"(At##8[m]), "v"(scl8)); } else { \
        _Pragma("unroll") for (int m = 0; m < 4; ++m) _Pragma("unroll") for (int n = 0; n < 2; ++n) _Pragma("unroll") for (int k = 0; k < 2; ++k) \
        acc[ai][bj][m][n] = __builtin_amdgcn_mfma_f32_16x16x32_bf16(Bt[n][k], At[m][k], acc[ai][bj][m][n], 0, 0, 0); } __builtin_amdgcn_s_setprio(0); } while (0)
#define PG8_WAIT_V(n) asm volatile("s_waitcnt vmcnt(" #n ")" ::: "memory")
#define PG8_WAIT_L(n) asm volatile("s_waitcnt lgkmcnt(" #n ")" ::: "memory")
#define PG8_BAR __builtin_amdgcn_s_barrier()
#define PG8_SCHED __builtin_amdgcn_sched_barrier(0)
    Unit cur, nxt; int ui = 0;
    if (!S.next(0, cur)) return;
    f32x4 acc[2][2][4][2];
#pragma unroll
    for (int a = 0; a < 2; ++a)
#pragma unroll
        for (int b = 0; b < 2; ++b)
#pragma unroll
            for (int m = 0; m < 4; ++m)
#pragma unroll
                for (int n = 0; n < 2; ++n) acc[a][b][m][n] = (f32x4){0.f, 0.f, 0.f, 0.f};
    bf16x8 At[4][2], B0[2][2], B1[2][2]; v8i_t At8[4], B08[2], B18[2]; int scl8 = 0x7F7F7F7F; asm volatile("" : "+v"(scl8));
    const char* cA = (const char*)(g.A + (size_t)cur.z * g.sAz + (size_t)cur.pm * BM * g.lda); const char* cB = (const char*)(g.Bt + (size_t)cur.z * g.sBz + (size_t)cur.pn * BM * g.ldb);
    typename epi_state<Epi>::type est; if constexpr (epi_state<Epi>::has) E.prefetch(est, cur, wr, wc, fr, fq);
    S.a_ready(cur);
    if constexpr (SP2) {
        PG8_STAGE(PG8_SB(0, 0), cB, voffB); PG8_STAGE(PG8_SB(0, 1), cB + hstepB, voffB); PG8_STAGE(PG8_SA(0, 0), cA, voffA); PG8_STAGE(PG8_SA(0, 1), cA + hstepA, voffA);
        if (wr == 1) PG8_BAR;
        PG8_WAIT_V(2); PG8_BAR;
        PG8_STAGE(PG8_SB(1, 0), cB + kstep, voffB); PG8_STAGE(PG8_SA(1, 0), cA + kstep, voffA); PG8_STAGE(PG8_SB(1, 1), cB + hstepB + kstep, voffB);
        PG8_WAIT_V(6); PG8_BAR;
    } else {
        PG8_STAGE(PG8_SB(0, 0), cB, voffB); PG8_STAGE(PG8_SA(0, 0), cA, voffA); PG8_STAGE(PG8_SB(0, 1), cB + hstepB, voffB); PG8_STAGE(PG8_SA(0, 1), cA + hstepA, voffA);
        if (wr == 1) PG8_BAR;
        PG8_WAIT_V(4); PG8_BAR;
        PG8_STAGE(PG8_SB(1, 0), cB + kstep, voffB); PG8_STAGE(PG8_SA(1, 0), cA + kstep, voffA); PG8_STAGE(PG8_SB(1, 1), cB + hstepB + kstep, voffB);
        PG8_WAIT_V(6); PG8_BAR;
    }
    for (;;) {
        const bool has_next = S.next(ui + 1, nxt);
        const char* nA = has_next ? (const char*)(g.A + (size_t)nxt.z * g.sAz + (size_t)nxt.pm * BM * g.lda) : cA; const char* nB = has_next ? (const char*)(g.Bt + (size_t)nxt.z * g.sBz + (size_t)nxt.pn * BM * g.ldb) : cB;
        for (int t = 0; t < nt; t += 2) {
            const bool last = (t == nt - 2);
            const char* a1 = cA + (size_t)(t + 1) * kstep;
            const char* a2 = last ? nA : cA + (size_t)(t + 2) * kstep; const char* b2 = last ? nB : cB + (size_t)(t + 2) * kstep;
            const char* a3 = a2 + kstep; const char* b3 = b2 + kstep;
            if (last && has_next) S.a_ready(nxt);
            if constexpr (SP2) {
            PG8_LDB(B0, 0, 0); PG8_LDB(B1, 0, 1); PG8_SCHED; PG8_LDA(At, 0, 0); PG8_STAGE(PG8_SA(1, 1), a1 + hstepA, voffA);
            PG8_WAIT_V(8); PG8_WAIT_L(0); PG8_BAR; PG8_MMA(0, 0, At, B0); PG8_MMA(0, 1, At, B1); PG8_BAR; PG8_SCHED;
            PG8_LDA(At, 0, 1); PG8_STAGE(PG8_SB(0, 0), b2, voffB); PG8_STAGE(PG8_SB(0, 1), b2 + hstepB, voffB); PG8_STAGE(PG8_SA(0, 0), a2, voffA);
            PG8_WAIT_V(8); PG8_WAIT_L(0); PG8_BAR; PG8_MMA(1, 0, At, B0); PG8_MMA(1, 1, At, B1); PG8_BAR; PG8_SCHED;
            PG8_LDB(B0, 1, 0); PG8_LDB(B1, 1, 1); PG8_SCHED; PG8_LDA(At, 1, 0); PG8_STAGE(PG8_SA(0, 1), a2 + hstepA, voffA);
            PG8_WAIT_V(8); PG8_WAIT_L(0); PG8_BAR; PG8_MMA(0, 0, At, B0); PG8_MMA(0, 1, At, B1); PG8_BAR; PG8_SCHED;
            PG8_LDA(At, 1, 1); PG8_STAGE(PG8_SB(1, 0), b3, voffB); PG8_STAGE(PG8_SB(1, 1), b3 + hstepB, voffB); PG8_STAGE(PG8_SA(1, 0), a3, voffA);
            PG8_WAIT_V(8); PG8_WAIT_L(0); PG8_BAR; PG8_MMA(1, 0, At, B0); PG8_MMA(1, 1, At, B1); PG8_BAR; PG8_SCHED;
            } else {
            PG8_LDB(B0, 0, 0); PG8_SCHED; PG8_LDA(At, 0, 0); PG8_STAGE(PG8_SA(1, 1), a1 + hstepA, voffA);
            PG8_WAIT_L(8); PG8_BAR; PG8_WAIT_L(0); PG8_MMA(0, 0, At, B0); PG8_BAR; PG8_SCHED;
            PG8_LDB(B1, 0, 1); PG8_STAGE(PG8_SB(0, 0), b2, voffB);
            PG8_BAR; PG8_WAIT_L(0); PG8_MMA(0, 1, At, B1); PG8_BAR;
            PG8_LDA(At, 0, 1); PG8_STAGE(PG8_SA(0, 0), a2, voffA);
            PG8_BAR; PG8_WAIT_L(0); PG8_MMA(1, 0, At, B0); PG8_BAR; PG8_SCHED;
            PG8_STAGE(PG8_SB(0, 1), b2 + hstepB, voffB);
            PG8_WAIT_V(6); PG8_BAR; PG8_MMA(1, 1, At, B1); PG8_BAR;
            PG8_LDB(B0, 1, 0); PG8_SCHED; PG8_LDA(At, 1, 0); PG8_STAGE(PG8_SA(0, 1), a2 + hstepA, voffA);
            PG8_WAIT_L(8); PG8_BAR; PG8_WAIT_L(0); PG8_MMA(0, 0, At, B0); PG8_BAR; PG8_SCHED;
            PG8_LDB(B1, 1, 1); PG8_STAGE(PG8_SB(1, 0), b3, voffB);
            PG8_BAR; PG8_WAIT_L(0); PG8_MMA(0, 1, At, B1); PG8_BAR;
            PG8_LDA(At, 1, 1); PG8_STAGE(PG8_SA(1, 0), a3, voffA);
            PG8_BAR; PG8_WAIT_L(0); PG8_MMA(1, 0, At, B0); PG8_BAR; PG8_SCHED;
            PG8_STAGE(PG8_SB(1, 1), b3 + hstepB, voffB);
            PG8_WAIT_V(6); PG8_BAR; PG8_MMA(1, 1, At, B1); PG8_BAR;
            }
        }
        if constexpr (F8) asm volatile("s_nop 15\n\ts_nop 7" ::: "memory");
        if constexpr (ALIGN_EPI) { if (wr == 0) PG8_BAR; }
        if constexpr (!Epi::AFTER_DRAIN) { if constexpr (epi_state<Epi>::has) E(acc, cur, wr, wc, fr, fq, est); else E(acc, cur, wr, wc, fr, fq); S.done(cur); }
        if (!has_next) break;
#pragma unroll
        for (int a = 0; a < 2; ++a)
#pragma unroll
            for (int b = 0; b < 2; ++b)
#pragma unroll
                for (int m = 0; m < 4; ++m)
#pragma unroll
                    for (int n = 0; n < 2; ++n) acc[a][b][m][n] = (f32x4){0.f, 0.f, 0.f, 0.f};
        cur = nxt; cA = nA; cB = nB; ++ui; if constexpr (epi_state<Epi>::has) E.prefetch(est, cur, wr, wc, fr, fq);
        if constexpr (ALIGN_EPI) { if (wr == 1) PG8_BAR; }
    }
    PG8_WAIT_V(0);
    if constexpr (!ALIGN_EPI) { if (wr == 0) PG8_BAR; }
    PG8_BAR;
    if constexpr (Epi::AFTER_DRAIN) { E.fused(acc, cur, wr, wc, fr, fq, lds, wid, lane); S.done(cur); }
#undef PG8_SA
#undef PG8_SB
#undef PG8_STAGE
#undef PG8_LDA
#undef PG8_LDB
#undef PG8_MMA
#undef PG8_WAIT_V
#undef PG8_WAIT_L
#undef PG8_BAR
#undef PG8_SCHED
}
}


constexpr int T_ = 8192, DM = 4096, INW = 14336;
constexpr int MH = 16, MW = 2048, NBLK = 32;
constexpr int RH = 8;
constexpr int PH = 8, NEXP = 16384;
constexpr float NORM_EPS = 1e-6f, GN_EPS = 1e-6f;
constexpr float LOG2E = 1.4426950408889634f;
constexpr float QSCALE = 0.08838834764831845f * 1.4426950408889634f;

constexpr size_t MiB = 1u << 20;
constexpr size_t WS_CTL = 0, CTL_ZERO_BYTES = 1 * MiB;
constexpr size_t WS_TAB = 1 * MiB;
constexpr size_t TAB_BIAS = WS_TAB, TAB_KMEAN = WS_TAB + 65536, TAB_KEYS = WS_TAB + 524288;
constexpr size_t WS_ROPE = 2 * MiB;
constexpr size_t WS_WIN_T = 10 * MiB;
constexpr size_t WS_WIN8 = WS_WIN_T, WS_WINB = WS_WIN_T + 24 * MiB;
constexpr size_t WS_PROJ = 122 * MiB;
constexpr size_t PROJ_STRIDE = (size_t)T_ * 2048;
constexpr size_t WS_XN = 346 * MiB;
constexpr size_t WS_MIX = 410 * MiB;
constexpr size_t WS_WOUT_T = 474 * MiB;
constexpr size_t WS_WQ_T = 506 * MiB;
constexpr size_t WS_H1 = 522 * MiB;
constexpr size_t WS_U8 = 650 * MiB;
constexpr size_t WS_V8T = 714 * MiB;
constexpr size_t WS_W8 = 778 * MiB;
constexpr size_t WS_FREE = 906 * MiB;
constexpr size_t WS_END = 1024 * MiB;
constexpr size_t WS_PQ = WS_WIN_T;
constexpr size_t WS_KT = WS_WIN_T + 64 * MiB;
constexpr size_t WS_UT = WS_XN;
constexpr size_t WS_VS = WS_FREE;
constexpr size_t WS_LIST = WS_FREE + 64 * MiB;
constexpr size_t WS_ML = WS_FREE + 80 * MiB;
constexpr size_t WS_PART = WS_H1;
constexpr size_t WS_GW = WS_WIN_T;
constexpr size_t WS_PQP = WS_WIN_T + 256 * MiB;
constexpr size_t WS_XN8 = 410 * MiB;
constexpr size_t WS_BM = WS_FREE + 32 * MiB;
constexpr size_t WS_TN8 = WS_FREE;
constexpr float WIN8_SCALE = 1024.f, XN8_SCALE = 16.f;
constexpr float TN8_SCALE = 16.f, U8_SCALE = 1024.f, V8_SCALE = 32.f, W8_SCALE = 32.f;
static_assert(WS_PQP + 32 * MiB <= WS_XN && WS_ML + 4 * MiB <= WS_END && WS_KT + 32 * MiB <= WS_PROJ, "d_ws map");
constexpr int CW_BAR = 4096;
constexpr int CW_CNT = 16384;

constexpr int RING_BYTES = 155648;
constexpr int LDSCTL_OFF = RING_BYTES, MISC_OFF = LDSCTL_OFF + 64;
constexpr int LDS_BYTES = RING_BYTES + 256;

#define GAS __attribute__((address_space(1)))
#define LAS __attribute__((address_space(3)))
typedef unsigned short bf16;
typedef unsigned v4u __attribute__((ext_vector_type(4)));
typedef unsigned v2u __attribute__((ext_vector_type(2)));
typedef float f32x4 __attribute__((ext_vector_type(4)));
typedef float f32x2 __attribute__((ext_vector_type(2)));
typedef float f32x16 __attribute__((ext_vector_type(16)));
typedef short bf16x8 __attribute__((ext_vector_type(8)));
typedef short s16x4 __attribute__((ext_vector_type(4)));
typedef short s16x2 __attribute__((ext_vector_type(2)));
typedef short v4i16_t __attribute__((ext_vector_type(4)));
#define LDS_WAIT() asm volatile("s_waitcnt lgkmcnt(0)" ::: "memory")
#define VM_WAIT() asm volatile("s_waitcnt vmcnt(0)" ::: "memory")
__device__ __forceinline__ unsigned f2bf(float f) { unsigned u = __builtin_bit_cast(unsigned, f); return (u + 0x7fffu + ((u >> 16) & 1u)) >> 16; }
__device__ __forceinline__ unsigned pk2(float lo, float hi) { return f2bf(lo) | (f2bf(hi) << 16); }
__device__ __forceinline__ float clamp448(float x) { return __builtin_fminf(__builtin_fmaxf(x, -448.f), 448.f); }
__device__ __forceinline__ unsigned pk4_fp8(float a, float b, float c, float d) { int r = 0; r = __builtin_amdgcn_cvt_pk_fp8_f32(clamp448(a), clamp448(b), r, false); r = __builtin_amdgcn_cvt_pk_fp8_f32(clamp448(c), clamp448(d), r, true); return (unsigned)r; }
__device__ __forceinline__ float bflo(unsigned w) { return __builtin_bit_cast(float, w << 16); }
__device__ __forceinline__ float bfhi(unsigned w) { return __builtin_bit_cast(float, w & 0xffff0000u); }

#define XB_TMO      128
#define XB_XCNT(j)  (256  + 64 * (j))
#define XB_XSUB(j)  (1280 + 64 * (j))
#define XB_XGEN(j)  (2304 + 64 * (j))
#define XB_TOP      3328
#define XB_TOPGEN   3392
#define XCD_BAR_WORDS 3456
#define XB_SPIN_CAP (1u << 18)

__device__ __forceinline__ unsigned xb_ld(unsigned* p)              { return __hip_atomic_load(p, __ATOMIC_RELAXED, __HIP_MEMORY_SCOPE_AGENT); }
__device__ __forceinline__ unsigned xb_add(unsigned* p, unsigned v) { return __hip_atomic_fetch_add(p, v, __ATOMIC_RELAXED, __HIP_MEMORY_SCOPE_AGENT); }
__device__ __forceinline__ unsigned xb_xcc_id() { return (unsigned)__builtin_amdgcn_s_getreg((3 << 11) | 20) & 0xFu; }
#define XB_SPIN(cond, bar) do { unsigned _sp = 0; while (cond) { __builtin_amdgcn_s_sleep(1); \
    if ((++_sp & 255u) == 0u) { if (xb_ld(&(bar)[XB_TMO])) break; if (_sp > XB_SPIN_CAP) { atomicAdd(&(bar)[XB_TMO], 1u); break; } } } } while (0)

struct XcdBarrier {
    unsigned* bar; unsigned x;
    volatile LAS unsigned* st;
};

__device__ __forceinline__ XcdBarrier xcd_barrier_post(unsigned* bar, volatile LAS unsigned* st) {
    XcdBarrier b; b.bar = bar; b.x = xb_xcc_id(); b.st = st;
    if (threadIdx.x == 0) (void)xb_add(&bar[XB_XCNT(b.x)], 1u);
    return b;
}
__device__ __forceinline__ void xcd_barrier_complete(unsigned* bar, unsigned x, unsigned& nloc, unsigned& nx) {
    const unsigned G = gridDim.x * gridDim.y * gridDim.z;
    unsigned sum, cnt, mine, sp = 0u;
    for (;;) {
        sum = 0u; cnt = 0u; mine = 0u;
#pragma unroll
        for (unsigned j = 0; j < 16; ++j) { const unsigned c = xb_ld(&bar[XB_XCNT(j)]); sum += c; cnt += (c > 0u) ? 1u : 0u; mine = (j == x) ? c : mine; }
        if (sum == G) break;
        __builtin_amdgcn_s_sleep(1);
        if ((++sp & 255u) == 0u) { if (xb_ld(&bar[XB_TMO])) break; if (sp > XB_SPIN_CAP) { atomicAdd(&bar[XB_TMO], 1u); break; } }
    }
    nloc = mine > 0u ? mine : 1u; nx = cnt > 0u ? cnt : 1u;
}

__device__ __forceinline__ void xcd_barrier(const XcdBarrier& b) {
    asm volatile("s_waitcnt vmcnt(0)" ::: "memory");
    __syncthreads();
    if (threadIdx.x == 0) {
        unsigned* bar = b.bar;
        __builtin_amdgcn_s_waitcnt(0);
        unsigned nloc = b.st[0], nx = b.st[1];
        if (nloc == 0u) { xcd_barrier_complete(bar, b.x, nloc, nx); b.st[0] = nloc; b.st[1] = nx; }
        const unsigned old = xb_add(&bar[XB_XSUB(b.x)], 1u);
        const unsigned gen = old / nloc;
        if (old + 1u == (gen + 1u) * nloc) {
            __builtin_amdgcn_fence(__ATOMIC_RELEASE, "agent");
            asm volatile("s_waitcnt vmcnt(0)" ::: "memory");
            const unsigned og = xb_add(&bar[XB_TOP], 1u);
            const unsigned tg = og / nx;
            if (og + 1u == (tg + 1u) * nx) xb_add(&bar[XB_TOPGEN], 1u);
            else XB_SPIN(xb_ld(&bar[XB_TOPGEN]) == tg, bar);
            __builtin_amdgcn_fence(__ATOMIC_ACQUIRE, "agent");
            xb_add(&bar[XB_XGEN(b.x)], 1u);
            asm volatile("s_waitcnt vmcnt(0)" ::: "memory");
        } else {
            XB_SPIN(xb_ld(&bar[XB_XGEN(b.x)]) == gen, bar);
            __builtin_amdgcn_fence(__ATOMIC_ACQUIRE, "agent");
            asm volatile("s_waitcnt vmcnt(0)" ::: "memory");
        }
    }
    __syncthreads();
}


struct Frame {
    LAS unsigned char* lds;
    int tid, lane, wave, G, gw, NGW;
};
__device__ __forceinline__ float wave_sum(float v) {
#pragma unroll
    for (int o = 1; o < 64; o <<= 1) v += __shfl_xor(v, o);
    return v;
}

__device__ __forceinline__ void p0_transpose_item(const float* W, int K, int N, int ldw, bf16* WT, LAS float* scr, int item, int lane) {
    const int nblk = N / 64, kb = item / nblk, nb = item % nblk, k0 = 64 * kb, n0 = 64 * nb;
    { const int c4 = lane & 15, kr = lane >> 4; f32x4 v[16];
#pragma unroll
      for (int i = 0; i < 16; ++i) v[i] = __builtin_nontemporal_load((const GAS f32x4*)(W + (size_t)(k0 + 4 * i + kr) * ldw + n0 + 4 * c4));
#pragma unroll
      for (int i = 0; i < 16; ++i) { const int k = 4 * i + kr; *(LAS f32x4*)(scr + k * 64 + ((c4 ^ ((k >> 3) & 15)) << 2)) = v[i]; } }
    LDS_WAIT(); asm volatile("" ::: "memory");
    const int c = lane & 7;
#pragma unroll
    for (int j = 0; j < 8; ++j) { const int n = (lane >> 3) + 8 * j; const LAS float* p = scr + (8 * c) * 64 + ((((n >> 2) ^ c) & 15) << 2) + (n & 3);
        v4u o; o.x = pk2(p[0 * 64], p[1 * 64]); o.y = pk2(p[2 * 64], p[3 * 64]); o.z = pk2(p[4 * 64], p[5 * 64]); o.w = pk2(p[6 * 64], p[7 * 64]);
        *(GAS v4u*)(WT + (size_t)(n0 + n) * K + k0 + 8 * c) = o; }
    LDS_WAIT(); asm volatile("" ::: "memory");
}
__device__ __forceinline__ void p0_transpose_item_fp8(const float* W, int K, int N, int ldw, unsigned char* WT, float scale, LAS float* scr, int item, int lane) {
    const int nblk = N / 32, kb = item / nblk, nb = item % nblk, k0 = 128 * kb, n0 = 32 * nb;
    { const int c4 = lane & 7, kr = lane >> 3; f32x4 v[16];
#pragma unroll
      for (int i = 0; i < 16; ++i) v[i] = __builtin_nontemporal_load((const GAS f32x4*)(W + (size_t)(k0 + 8 * i + kr) * ldw + n0 + 4 * c4));
#pragma unroll
      for (int i = 0; i < 16; ++i) { const int k = 8 * i + kr; *(LAS f32x4*)(scr + k * 32 + ((c4 ^ ((k >> 4) & 7)) << 2)) = v[i] * scale; } }
    LDS_WAIT(); asm volatile("" ::: "memory");
    const int c = lane & 7;
#pragma unroll
    for (int j = 0; j < 4; ++j) { const int n = (lane >> 3) + 8 * j; const LAS float* p = scr + (16 * c) * 32 + ((((n >> 2) ^ c) & 7) << 2) + (n & 3);
        v4u o; o.x = pk4_fp8(p[0 * 32], p[1 * 32], p[2 * 32], p[3 * 32]); o.y = pk4_fp8(p[4 * 32], p[5 * 32], p[6 * 32], p[7 * 32]);
        o.z = pk4_fp8(p[8 * 32], p[9 * 32], p[10 * 32], p[11 * 32]); o.w = pk4_fp8(p[12 * 32], p[13 * 32], p[14 * 32], p[15 * 32]);
        *(GAS v4u*)(WT + (size_t)(n0 + n) * K + k0 + 16 * c) = o; }
    LDS_WAIT(); asm volatile("" ::: "memory");
}
template <int MODE> __device__ __forceinline__ void rms_row_to_bf16(int lane, const float* xrow, const float* g, bf16* orow, unsigned char* o8row = nullptr) {
    const GAS f32x4* xr = (const GAS f32x4*)xrow + lane; const GAS f32x4* gr = (const GAS f32x4*)g + lane;
    f32x4 v[16]; float s = 0.f;
#pragma unroll
    for (int j = 0; j < 16; ++j) { v[j] = xr[64 * j]; s += (v[j].x * v[j].x + v[j].y * v[j].y) + (v[j].z * v[j].z + v[j].w * v[j].w); }
    const float rstd = 1.f / sqrtf(wave_sum(s) * (1.f / DM) + NORM_EPS);
    GAS v2u* o8 = (GAS v2u*)orow + lane;
#pragma unroll
    for (int j = 0; j < 16; ++j) { const f32x4 gg = gr[64 * j]; const f32x4 y = v[j] * rstd * gg; if constexpr (MODE != 2) { v2u w; w.x = pk2(y.x, y.y); w.y = pk2(y.z, y.w); o8[64 * j] = w; }
        if constexpr (MODE != 0) { const f32x4 ys = y * 16.f; ((GAS unsigned*)o8row)[lane + 64 * j] = pk4_fp8(ys.x, ys.y, ys.z, ys.w); } }
}
__constant__ unsigned char T5_BUCKET[129] = {0, 1, 2, 3, 4, 5, 6, 7, 8, 9, 10, 11, 12, 13, 14, 15, 16, 16, 16, 17, 17, 18, 18, 18, 19, 19, 19, 20, 20, 20, 20, 21, 21, 21, 21, 22, 22, 22, 22, 22, 23, 23, 23, 23, 23, 23, 24, 24, 24, 24, 24, 24, 25, 25, 25, 25, 25, 25, 25, 26, 26, 26, 26, 26, 26, 26, 26, 27, 27, 27, 27, 27, 27, 27, 27, 27, 27, 28, 28, 28, 28, 28, 28, 28, 28, 28, 28, 29, 29, 29, 29, 29, 29, 29, 29, 29, 29, 29, 29, 30, 30, 30, 30, 30, 30, 30, 30, 30, 30, 30, 30, 30, 30, 31, 31, 31, 31, 31, 31, 31, 31, 31, 31, 31, 31, 31, 31, 31, 31};

struct Args { const float* in[11]; float* out; unsigned char* ws; int ph_lo, ph_hi; };

__device__ __forceinline__ void p0_prologue(Frame& F, const Args& a) {
    unsigned char* ws = a.ws;
    LAS float* scr = (LAS float*)(F.lds + F.wave * 16384);
    const int gw = F.gw, NGW = F.NGW;
    const float* w_in = a.in[2]; const float* w_out = a.in[3]; const float* w_q = a.in[6]; const float* pv = a.in[9];
    constexpr int NMOBA = 3 * MW, NRET = INW - NMOBA;
    constexpr int I_INA = (DM / 128) * (NMOBA / 32), I_INB = (DM / 64) * (NRET / 64), I_OUT = (DM / 64) * (DM / 64), I_Q = (DM / 64) * (2048 / 64), I_V = (NEXP / 128) * (DM / 32);
    constexpr int NITEMS = I_INA + I_INB + I_OUT + I_Q + I_V;
    for (int it = gw; it < NITEMS; it += NGW) {
        int r = it;
        if (r < I_INA) { p0_transpose_item_fp8(w_in, DM, NMOBA, INW, ws + WS_WIN8, WIN8_SCALE, scr, r, F.lane); continue; } r -= I_INA;
        if (r < I_INB) { p0_transpose_item(w_in + NMOBA, DM, NRET, INW, (bf16*)(ws + WS_WINB), scr, r, F.lane); continue; } r -= I_INB;
        if (r < I_OUT) { p0_transpose_item(w_out, DM, DM, DM, (bf16*)(ws + WS_WOUT_T), scr, r, F.lane); continue; } r -= I_OUT;
        if (r < I_Q) { p0_transpose_item(w_q, DM, 2048, 2048, (bf16*)(ws + WS_WQ_T), scr, r, F.lane); continue; } r -= I_Q;
        p0_transpose_item_fp8(pv, NEXP, DM, DM, ws + WS_V8T, V8_SCALE, scr, r, F.lane);
    }
    { const GAS f32x4* src = (const GAS f32x4*)a.in[8]; GAS v4u* dst = (GAS v4u*)(ws + WS_U8);
      const size_t n16 = (size_t)NEXP * DM / 16, stride = (size_t)NGW * 64;
      for (size_t i0 = (size_t)gw * 64 + F.lane; i0 < n16; i0 += 4 * stride) { f32x4 x[4][4];
#pragma unroll
          for (int r = 0; r < 4; ++r) { const size_t i = i0 + r * stride; if (i < n16) {
#pragma unroll
              for (int q = 0; q < 4; ++q) x[r][q] = __builtin_nontemporal_load(src + 4 * i + q); } }
#pragma unroll
          for (int r = 0; r < 4; ++r) { const size_t i = i0 + r * stride; if (i < n16) { v4u o;
              o.x = pk4_fp8(x[r][0].x * U8_SCALE, x[r][0].y * U8_SCALE, x[r][0].z * U8_SCALE, x[r][0].w * U8_SCALE); o.y = pk4_fp8(x[r][1].x * U8_SCALE, x[r][1].y * U8_SCALE, x[r][1].z * U8_SCALE, x[r][1].w * U8_SCALE);
              o.z = pk4_fp8(x[r][2].x * U8_SCALE, x[r][2].y * U8_SCALE, x[r][2].z * U8_SCALE, x[r][2].w * U8_SCALE); o.w = pk4_fp8(x[r][3].x * U8_SCALE, x[r][3].y * U8_SCALE, x[r][3].z * U8_SCALE, x[r][3].w * U8_SCALE); dst[i] = o; } } } }
    { const GAS f32x4* src = (const GAS f32x4*)a.in[7]; GAS v4u* dst = (GAS v4u*)(ws + TAB_KEYS);
      const size_t n8 = (size_t)262144 / 8, stride = (size_t)NGW * 64;
      for (size_t i = (size_t)gw * 64 + F.lane; i < n8; i += stride) { const f32x4 x0 = src[2 * i], x1 = src[2 * i + 1]; v4u o; o.x = pk2(x0.x, x0.y); o.y = pk2(x0.z, x0.w); o.z = pk2(x1.x, x1.y); o.w = pk2(x1.z, x1.w); dst[i] = o; } }
    for (int m = gw; m < T_; m += NGW) rms_row_to_bf16<1>(F.lane, a.in[0] + (size_t)m * DM, a.in[1], (bf16*)(ws + WS_XN) + (size_t)m * DM, ws + WS_XN8 + (size_t)m * DM);
    { float* COS = (float*)(ws + WS_ROPE); float* SIN = COS + (size_t)T_ * 128;
      for (int i = gw * 64 + F.lane; i < T_ * 128; i += NGW * 64) { const int t = i >> 7, f = i & 127;
          const double inv = exp2(-(double)f * (13.287712379549449 / 128.0));
          const double rev = (double)t * inv * 0.15915494309189535;
          const float fr = (float)(rev - floor(rev));
          COS[i] = __builtin_amdgcn_cosf(fr); SIN[i] = __builtin_amdgcn_sinf(fr); } }
    { float* tb = (float*)(ws + TAB_BIAS); const float* rb = a.in[4];
      for (int i = gw * 64 + F.lane; i < 16 * 132; i += NGW * 64) { const int h = i / 132, n = i % 132; tb[i] = rb[(int)T5_BUCKET[n > 128 ? 128 : n] * 16 + h] * LOG2E; } }
}

namespace pg8 {
struct EpiResF32 {
    static constexpr bool PERM = false, AFTER_DRAIN = false;
    const float* base; float* C; int ldc; float scale;
    __device__ __forceinline__ void operator()(const f32x4 (&acc)[2][2][4][2], const Unit& u, int wr, int wc, int fr, int fq) const {
        const int row0 = u.pm * BM + wr * 64 + fr, col0 = u.pn * BM + wc * 32 + 4 * fq;
#pragma unroll
        for (int ai = 0; ai < 2; ++ai)
#pragma unroll
            for (int m = 0; m < 4; ++m) { const size_t off = (size_t)(row0 + ai * HALF + m * 16) * ldc + col0;
#pragma unroll
                for (int bj = 0; bj < 2; ++bj)
#pragma unroll
                    for (int n = 0; n < 2; ++n) { const f32x4 b = *(const f32x4*)(base + off + bj * HALF + n * 16); *(f32x4*)(C + off + bj * HALF + n * 16) = acc[ai][bj][m][n] * scale + b; } }
    }
};
struct EpiF32Z {
    static constexpr bool PERM = false, AFTER_DRAIN = false;
    float* C;
    __device__ __forceinline__ void operator()(const f32x4 (&acc)[2][2][4][2], const Unit& u, int wr, int wc, int fr, int fq) const {
        float* Cz = C + (size_t)u.z * 65536; const int row0 = wr * 64 + fr, col0 = wc * 32 + 4 * fq;
#pragma unroll
        for (int ai = 0; ai < 2; ++ai)
#pragma unroll
            for (int m = 0; m < 4; ++m) { float* rowp = Cz + (size_t)(row0 + ai * HALF + m * 16) * 256 + col0;
#pragma unroll
                for (int bj = 0; bj < 2; ++bj)
#pragma unroll
                    for (int n = 0; n < 2; ++n) *(f32x4*)(rowp + bj * HALF + n * 16) = acc[ai][bj][m][n]; }
    }
};
struct EpiRetP {
    static constexpr bool PERM = true, AFTER_DRAIN = false;
    bf16_t* PQ;
    __device__ __forceinline__ void operator()(const f32x4 (&acc)[2][2][4][2], const Unit& u, int wr, int wc, int fr, int fq) const {
        asm volatile("" : "+v"(fr), "+v"(fq));
        const int h = u.z; const float lg = __builtin_log2f(1.f - __builtin_exp2f(-5.f - (float)h));
        bf16_t* base = PQ + (size_t)(u.z * 32 + u.pm) * 131072;
#pragma unroll
        for (int ai = 0; ai < 2; ++ai)
#pragma unroll
            for (int m = 0; m < 4; ++m) { int i = ai * HALF + wr * 64 + m * 16 + fr;
                float lgv = lg; asm volatile("" : "+v"(lgv), "+v"(i));
#pragma unroll
                for (int bj = 0; bj < 2; ++bj) { const int j0 = bj * HALF + wc * 32 + 8 * fq; float v[8];
#pragma unroll
                    for (int e = 0; e < 8; ++e) { const int dd = i - (j0 + e); const float a = e < 4 ? acc[ai][bj][m][0][e & 3] : acc[ai][bj][m][1][e & 3];
                        v[e] = dd >= 0 ? a * __builtin_amdgcn_exp2f((float)dd * lgv) : 0.f; }
                    u32x4 w; w.x = cvt_pk_bf16(v[0], v[1]); w.y = cvt_pk_bf16(v[2], v[3]); w.z = cvt_pk_bf16(v[4], v[5]); w.w = cvt_pk_bf16(v[6], v[7]);
                    *(u32x4*)(base + (size_t)i * 512 + j0) = w; } }
    }
};
struct EpiRetOut {
    static constexpr bool PERM = true, AFTER_DRAIN = true;
    const bf16_t* RG; bf16_t* MIX;
    __device__ __forceinline__ void fused(f32x4 (&acc)[2][2][4][2], const Unit& u, int wr, int wc, int fr, int fq, PG8_LAS unsigned char* lds, int wid, int lane) const {
        PG8_LAS f32x2* P = (PG8_LAS f32x2*)lds;
#pragma unroll
        for (int ai = 0; ai < 2; ++ai)
#pragma unroll
            for (int m = 0; m < 4; ++m) { float s = 0.f, q = 0.f;
#pragma unroll
                for (int bj = 0; bj < 2; ++bj)
#pragma unroll
                    for (int n = 0; n < 2; ++n) { const f32x4 x = acc[ai][bj][m][n]; s += (x[0] + x[1]) + (x[2] + x[3]); q += (x[0] * x[0] + x[1] * x[1]) + (x[2] * x[2] + x[3] * x[3]); }
                s += __shfl_xor(s, 16); s += __shfl_xor(s, 32); q += __shfl_xor(q, 16); q += __shfl_xor(q, 32);
                if (fq == 0) P[(ai * HALF + wr * 64 + m * 16 + fr) * 4 + wc] = (f32x2){s, q}; }
        asm volatile("s_waitcnt lgkmcnt(0)" ::: "memory"); __builtin_amdgcn_s_barrier(); asm volatile("" ::: "memory");
        const int h = u.z >> 5, c = u.z & 31;
#pragma unroll
        for (int ai = 0; ai < 2; ++ai)
#pragma unroll
            for (int m = 0; m < 4; ++m) { const int i = ai * HALF + wr * 64 + m * 16 + fr;
                const f32x2 p0 = P[i * 4 + 0], p1 = P[i * 4 + 1], p2 = P[i * 4 + 2], p3 = P[i * 4 + 3];
                const float mean = ((p0.x + p1.x) + (p2.x + p3.x)) * (1.f / 256.f); float var = ((p0.y + p1.y) + (p2.y + p3.y)) * (1.f / 256.f) - mean * mean; var = var < 0.f ? 0.f : var;
                const float rstd = 1.f / sqrtf(var + 1e-6f);
                const size_t t = (size_t)c * 256 + i;
#pragma unroll
                for (int bj = 0; bj < 2; ++bj) { const int e0 = bj * HALF + wc * 32 + 8 * fq;
                    const u32x4 gw = *(const u32x4*)(RG + t * 2048 + h * 256 + e0); float g[8];
                    g[0] = __builtin_bit_cast(float, gw.x << 16); g[1] = __builtin_bit_cast(float, gw.x & 0xffff0000u); g[2] = __builtin_bit_cast(float, gw.y << 16); g[3] = __builtin_bit_cast(float, gw.y & 0xffff0000u);
                    g[4] = __builtin_bit_cast(float, gw.z << 16); g[5] = __builtin_bit_cast(float, gw.z & 0xffff0000u); g[6] = __builtin_bit_cast(float, gw.w << 16); g[7] = __builtin_bit_cast(float, gw.w & 0xffff0000u);
                    float v[8];
#pragma unroll
                    for (int e = 0; e < 8; ++e) { const float a = e < 4 ? acc[ai][bj][m][0][e & 3] : acc[ai][bj][m][1][e & 3]; const float y = (a - mean) * rstd;
                        const float sg = g[e] * __builtin_amdgcn_rcpf(1.f + __builtin_amdgcn_exp2f(-g[e] * 1.4426950408889634f)); v[e] = y * sg; }
                    u32x4 w; w.x = cvt_pk_bf16(v[0], v[1]); w.y = cvt_pk_bf16(v[2], v[3]); w.z = cvt_pk_bf16(v[4], v[5]); w.w = cvt_pk_bf16(v[6], v[7]);
                    *(u32x4*)(MIX + t * 4096 + 2048 + h * 256 + e0) = w; } }
    }
};
template <int MODE> struct EpiPeerW8 {
    static constexpr bool PERM = true, AFTER_DRAIN = false;
    const bf16_t* G; const unsigned* BMP; unsigned char* W8; float sacc, sw;
    struct State { unsigned bm[8]; };
    __device__ __forceinline__ void prefetch(State& st, const Unit& u, int wr, int wc, int fr, int fq) const {
        const int row0 = u.pm * BM + wr * 64 + fr;
#pragma unroll
        for (int ai = 0; ai < 2; ++ai)
#pragma unroll
            for (int m = 0; m < 4; ++m) st.bm[ai * 4 + m] = MODE == 2 ? 0u : BMP[(size_t)(row0 + ai * HALF + m * 16) * 64 + u.pn];
    }
    __device__ __forceinline__ void operator()(const f32x4 (&acc)[2][2][4][2], const Unit& u, int wr, int wc, int fr, int fq, const State& st) const {
        const int row0 = u.pm * BM + wr * 64 + fr, col0 = u.pn * BM + wc * 32 + 8 * fq;
        typedef unsigned u32x2 __attribute__((ext_vector_type(2)));
        u32x4 gwv[2][4][2];
#pragma unroll
        for (int ai = 0; ai < 2; ++ai)
#pragma unroll
            for (int m = 0; m < 4; ++m) { const size_t ro = (size_t)(row0 + ai * HALF + m * 16) * 16384 + col0;
                const unsigned bm = MODE == 2 ? (unsigned)((row0 + m) * 2654435761u) & (unsigned)(((row0 + m) * 40503u) >> 3) & (unsigned)((row0 + m) * 97u) : st.bm[ai * 4 + m];
#pragma unroll
                for (int bj = 0; bj < 2; ++bj) { gwv[ai][m][bj] = (u32x4){0u, 0u, 0u, 0u};
                    if ((bm >> (16 * bj + 4 * wc + fq)) & 1u) gwv[ai][m][bj] = MODE == 2 ? (u32x4){0x3f803f80u, 0x3f803f80u, 0x3f803f80u, 0x3f803f80u} : *(const u32x4*)(G + ro + bj * HALF); } }
#pragma unroll
        for (int ai = 0; ai < 2; ++ai)
#pragma unroll
            for (int m = 0; m < 4; ++m) { const size_t ro = (size_t)(row0 + ai * HALF + m * 16) * 16384 + col0;
#pragma unroll
                for (int bj = 0; bj < 2; ++bj) { unsigned w0 = 0u, w1 = 0u; const u32x4 gw = gwv[ai][m][bj];
                    if ((gw.x | gw.y | gw.z | gw.w) != 0u) {
                        const f32x4 v0 = acc[ai][bj][m][0] * sacc, v1 = acc[ai][bj][m][1] * sacc;
                        f32x2 a = (f32x2){v0[0], v0[1]}, b = (f32x2){v0[2], v0[3]}, c = (f32x2){v1[0], v1[1]}, d = (f32x2){v1[2], v1[3]};
                        if constexpr (MODE == 0) { a = gelu_pk(a); b = gelu_pk(b); c = gelu_pk(c); d = gelu_pk(d); }
                        float r[8];
                        r[0] = a.x * __builtin_bit_cast(float, gw.x << 16); r[1] = a.y * __builtin_bit_cast(float, gw.x & 0xffff0000u);
                        r[2] = b.x * __builtin_bit_cast(float, gw.y << 16); r[3] = b.y * __builtin_bit_cast(float, gw.y & 0xffff0000u);
                        r[4] = c.x * __builtin_bit_cast(float, gw.z << 16); r[5] = c.y * __builtin_bit_cast(float, gw.z & 0xffff0000u);
                        r[6] = d.x * __builtin_bit_cast(float, gw.w << 16); r[7] = d.y * __builtin_bit_cast(float, gw.w & 0xffff0000u);
                        int t0 = 0, t1 = 0;
                        t0 = __builtin_amdgcn_cvt_pk_fp8_f32(r[0] * sw, r[1] * sw, t0, false); t0 = __builtin_amdgcn_cvt_pk_fp8_f32(r[2] * sw, r[3] * sw, t0, true);
                        t1 = __builtin_amdgcn_cvt_pk_fp8_f32(r[4] * sw, r[5] * sw, t1, false); t1 = __builtin_amdgcn_cvt_pk_fp8_f32(r[6] * sw, r[7] * sw, t1, true);
                        w0 = (unsigned)t0; w1 = (unsigned)t1; }
                    *(u32x2*)(W8 + ro + bj * HALF) = (u32x2){w0, w1}; } }
    }
};
struct BatchOrder {
    int nz, G, c;
    __device__ bool next(int i, Unit& u) const { const int L = i * G + c; if (L >= nz) return false; u.pm = 0; u.pn = 0; u.z = L; return true; }
    __device__ __forceinline__ void a_ready(const Unit&) const {}
    __device__ __forceinline__ void done(const Unit&) const {}
};
struct HOrder { int G, c; __device__ bool next(int i, Unit& u) const { const int L = i * G + c; if (L >= 256) return false; u.z = L >> 5; u.pm = L & 31; u.pn = L & 31; return true; }
                __device__ __forceinline__ void a_ready(const Unit&) const {} __device__ __forceinline__ void done(const Unit&) const {} };
struct OneOrder { int z; __device__ bool next(int i, Unit& u) const { if (i > 0 || z >= 256) return false; u.pm = 0; u.pn = 0; u.z = z; return true; }
                  __device__ __forceinline__ void a_ready(const Unit&) const {} __device__ __forceinline__ void done(const Unit&) const {} };
}

__device__ __forceinline__ int tr_off(int d, int j) { return d * 512 + ((((j >> 3) ^ (d >> 3)) & 31) << 4) + ((j & 7) << 1); }
__device__ __forceinline__ void unpack8(const v4u w, float (&f)[8]) { f[0] = bflo(w.x); f[1] = bfhi(w.x); f[2] = bflo(w.y); f[3] = bfhi(w.y); f[4] = bflo(w.z); f[5] = bfhi(w.z); f[6] = bflo(w.w); f[7] = bfhi(w.w); }
__device__ __forceinline__ v4u pack8(const float (&f)[8]) { v4u o; o.x = pk2(f[0], f[1]); o.y = pk2(f[2], f[3]); o.z = pk2(f[4], f[5]); o.w = pk2(f[6], f[7]); return o; }

template <bool NOSTORE> __device__ __forceinline__ void p2_prep(Frame& F, unsigned char* ws) {
    bf16* RQ = (bf16*)(ws + WS_PROJ) + 3 * PROJ_STRIDE; bf16* RK = RQ + PROJ_STRIDE; bf16* RV = RK + PROJ_STRIDE;
    const float* COS = (const float*)(ws + WS_ROPE); const float* SIN = COS + (size_t)T_ * 128;
    bf16* PQ = (bf16*)(ws + WS_PQ); bf16* KT = (bf16*)(ws + WS_KT); bf16* VS = (bf16*)(ws + WS_VS);
    LAS unsigned char* Tl = F.lds;
    const int l16 = F.tid & 15, trow = F.tid >> 4, d0 = l16 * 8;
    for (int item = blockIdx.x; item < 256; item += F.G) {
        const int h = item >> 5, c = item & 31;
        const float lg = __builtin_log2f(1.f - __builtin_exp2f(-5.f - (float)h));
#pragma unroll 2
        for (int step = 0; step < 8; ++step) {
            const int j = step * 32 + trow; const size_t t = (size_t)c * 256 + j;
            bf16* kp = RK + t * 2048 + h * 256 + d0;
            float lo[8], hi[8], cs[8], sn[8];
            unpack8(*(const GAS v4u*)kp, lo); unpack8(*(const GAS v4u*)(kp + 128), hi);
            { const f32x4 c0 = *(const GAS f32x4*)(COS + t * 128 + d0), c1 = *(const GAS f32x4*)(COS + t * 128 + d0 + 4), s0 = *(const GAS f32x4*)(SIN + t * 128 + d0), s1 = *(const GAS f32x4*)(SIN + t * 128 + d0 + 4);
              cs[0] = c0.x; cs[1] = c0.y; cs[2] = c0.z; cs[3] = c0.w; cs[4] = c1.x; cs[5] = c1.y; cs[6] = c1.z; cs[7] = c1.w;
              sn[0] = s0.x; sn[1] = s0.y; sn[2] = s0.z; sn[3] = s0.w; sn[4] = s1.x; sn[5] = s1.y; sn[6] = s1.z; sn[7] = s1.w; }
            float nl[8], nh[8];
#pragma unroll
            for (int i = 0; i < 8; ++i) { nl[i] = (lo[i] * cs[i] - hi[i] * sn[i]) * 0.0625f; nh[i] = (lo[i] * sn[i] + hi[i] * cs[i]) * 0.0625f; }
            if constexpr (!NOSTORE) { *(GAS v4u*)kp = pack8(nl); *(GAS v4u*)(kp + 128) = pack8(nh); }
            const float dec = __builtin_amdgcn_exp2f((float)(255 - j) * lg);
#pragma unroll
            for (int i = 0; i < 8; ++i) { *(LAS bf16*)(Tl + tr_off(d0 + i, j)) = (bf16)f2bf(nl[i] * dec); *(LAS bf16*)(Tl + tr_off(128 + d0 + i, j)) = (bf16)f2bf(nh[i] * dec); }
        }
        LDS_WAIT(); __syncthreads();
#pragma unroll 4
        for (int n = 0; n < 16; ++n) { const int id = F.tid + 512 * n, d = id >> 5, chp = id & 31, jl = (chp ^ (d >> 3)) & 31;
            const v4u tv = *(const LAS v4u*)(Tl + d * 512 + chp * 16); if constexpr (!NOSTORE) *(GAS v4u*)(KT + (size_t)item * 65536 + d * 256 + jl * 8) = tv; else if (tv.x == 0x12345678u && tv.y == 0x9abcdef0u) *(GAS v4u*)(KT + (size_t)item * 65536 + d * 256 + jl * 8) = tv; }
        LDS_WAIT(); __syncthreads();
#pragma unroll 4
        for (int step = 0; step < 8; ++step) {
            const int j = step * 32 + trow; const size_t t = (size_t)c * 256 + j;
            const bf16* vp = RV + t * 2048 + h * 256 + d0;
            const v4u a = *(const GAS v4u*)vp, b = *(const GAS v4u*)(vp + 128);
            const unsigned aw[4] = {a.x, a.y, a.z, a.w}, bw[4] = {b.x, b.y, b.z, b.w};
#pragma unroll
            for (int i = 0; i < 8; ++i) { *(LAS bf16*)(Tl + tr_off(d0 + i, j)) = (bf16)((i & 1) ? (aw[i >> 1] >> 16) : (aw[i >> 1] & 0xffffu)); *(LAS bf16*)(Tl + tr_off(128 + d0 + i, j)) = (bf16)((i & 1) ? (bw[i >> 1] >> 16) : (bw[i >> 1] & 0xffffu)); }
        }
        LDS_WAIT(); __syncthreads();
#pragma unroll 4
        for (int n = 0; n < 16; ++n) { const int id = F.tid + 512 * n, d = id >> 5, chp = id & 31, jl = (chp ^ (d >> 3)) & 31;
            const v4u tv = *(const LAS v4u*)(Tl + d * 512 + chp * 16); if constexpr (!NOSTORE) *(GAS v4u*)(VS + (size_t)item * 131072 + d * 512 + jl * 8) = tv; else if (tv.x == 0x12345678u && tv.y == 0x9abcdef0u) *(GAS v4u*)(VS + (size_t)item * 131072 + d * 512 + jl * 8) = tv; }
        LDS_WAIT(); __syncthreads();
#pragma unroll 2
        for (int step = 0; step < 8; ++step) {
            const int j = step * 32 + trow; const size_t t = (size_t)c * 256 + j;
            bf16* qp = RQ + t * 2048 + h * 256 + d0;
            float lo[8], hi[8], cs[8], sn[8];
            unpack8(*(const GAS v4u*)qp, lo); unpack8(*(const GAS v4u*)(qp + 128), hi);
            { const f32x4 c0 = *(const GAS f32x4*)(COS + t * 128 + d0), c1 = *(const GAS f32x4*)(COS + t * 128 + d0 + 4), s0 = *(const GAS f32x4*)(SIN + t * 128 + d0), s1 = *(const GAS f32x4*)(SIN + t * 128 + d0 + 4);
              cs[0] = c0.x; cs[1] = c0.y; cs[2] = c0.z; cs[3] = c0.w; cs[4] = c1.x; cs[5] = c1.y; cs[6] = c1.z; cs[7] = c1.w;
              sn[0] = s0.x; sn[1] = s0.y; sn[2] = s0.z; sn[3] = s0.w; sn[4] = s1.x; sn[5] = s1.y; sn[6] = s1.z; sn[7] = s1.w; }
            float nl[8], nh[8];
#pragma unroll
            for (int i = 0; i < 8; ++i) { nl[i] = lo[i] * cs[i] - hi[i] * sn[i]; nh[i] = lo[i] * sn[i] + hi[i] * cs[i]; }
            if constexpr (!NOSTORE) { *(GAS v4u*)qp = pack8(nl); *(GAS v4u*)(qp + 128) = pack8(nh); }
            const float dec = __builtin_amdgcn_exp2f((float)(j + 1) * lg);
#pragma unroll
            for (int i = 0; i < 8; ++i) { nl[i] *= dec; nh[i] *= dec; }
            bf16* pq = PQ + (size_t)item * 131072 + (size_t)j * 512 + 256 + d0;
            if constexpr (!NOSTORE) { *(GAS v4u*)pq = pack8(nl); *(GAS v4u*)(pq + 128) = pack8(nh); } else if (nl[0] == 1.2345e30f) { *(GAS v4u*)pq = pack8(nl); *(GAS v4u*)(pq + 128) = pack8(nh); }
        }
    }
    { const bf16* MK = (const bf16*)(ws + WS_PROJ) + PROJ_STRIDE; float* KM = (float*)(ws + TAB_KMEAN);
      const int ll = F.lane & 15, rg = F.lane >> 4;
      for (int it = F.gw; it < 512; it += F.NGW) { const int j = it >> 4, h = it & 15;
          float acc[8] = {0.f, 0.f, 0.f, 0.f, 0.f, 0.f, 0.f, 0.f};
#pragma unroll 8
          for (int i = 0; i < 64; ++i) { const int r = rg + 4 * i; float f[8]; unpack8(*(const GAS v4u*)(MK + (size_t)(j * 256 + r) * 2048 + h * 128 + ll * 8), f);
#pragma unroll
              for (int e = 0; e < 8; ++e) acc[e] += f[e]; }
#pragma unroll
          for (int e = 0; e < 8; ++e) { acc[e] += __shfl_xor(acc[e], 16); acc[e] += __shfl_xor(acc[e], 32); }
          if (rg == 0) { GAS f32x4* o = (GAS f32x4*)(KM + (size_t)(j * 16 + h) * 128 + ll * 8);
              o[0] = (f32x4){acc[0], acc[1], acc[2], acc[3]} * (1.f / 256.f); o[1] = (f32x4){acc[4], acc[5], acc[6], acc[7]} * (1.f / 256.f); } } }
}

template <bool NOSTORE> __device__ __forceinline__ void p3_gating(Frame& F, unsigned char* ws) {
    const bf16* MQ = (const bf16*)(ws + WS_PROJ); const float* KM = (const float*)(ws + TAB_KMEAN);
    unsigned* CNT = (unsigned*)(ws + WS_CTL) + CW_CNT; unsigned* LIST = (unsigned*)(ws + WS_LIST);
    LAS float* kml = (LAS float*)F.lds;
    for (int item = blockIdx.x; item < 256; item += F.G) {
        const int h = item >> 4, grp = item & 15;
        __syncthreads();
        for (int i = F.tid; i < 32 * 32; i += 512) { const int j = i >> 5, c4 = i & 31; *(LAS f32x4*)(kml + j * 128 + c4 * 4) = *(const GAS f32x4*)(KM + (size_t)(j * 16 + h) * 128 + c4 * 4); }
        LDS_WAIT(); __syncthreads();
        const int q = grp * 512 + F.wave * 64 + F.lane, cur = (grp * 512 + F.wave * 64) >> 8;
        float qv[128];
#pragma unroll
        for (int k = 0; k < 16; ++k) { float f[8]; unpack8(*(const GAS v4u*)(MQ + (size_t)q * 2048 + h * 128 + k * 8), f);
#pragma unroll
            for (int e = 0; e < 8; ++e) qv[k * 8 + e] = f[e]; }
        float v1 = -__builtin_inff(), v2 = v1, v3 = v1; int i1 = 0, i2 = 0, i3 = 0;
        for (int j = 0; j < cur; ++j) { float g0 = 0.f, g1 = 0.f;
#pragma unroll
            for (int k = 0; k < 32; ++k) { const f32x4 kk = *(const LAS f32x4*)(kml + j * 128 + k * 4); g0 += qv[4 * k] * kk.x; g1 += qv[4 * k + 1] * kk.y; g0 += qv[4 * k + 2] * kk.z; g1 += qv[4 * k + 3] * kk.w; }
            const float g = g0 + g1;
            if (g > v1) { v3 = v2; i3 = i2; v2 = v1; i2 = i1; v1 = g; i1 = j; } else if (g > v2) { v3 = v2; i3 = i2; v2 = g; i2 = j; } else if (g > v3) { v3 = g; i3 = j; } }
        int nsel = cur < 3 ? cur : 3;
        if constexpr (NOSTORE) { if (v1 + v2 + v3 != 1.2345e30f) nsel = 0; }
        for (int s = 0; s < nsel; ++s) { const int blk = s == 0 ? i1 : (s == 1 ? i2 : i3);
            unsigned long long rem = __ballot(1);
            while (rem) { const int leader = __builtin_ctzll(rem); const int b = __builtin_amdgcn_readlane(blk, leader);
                const unsigned long long mask = __ballot(blk == b); const int n = __builtin_popcountll(mask);
                unsigned basep = 0; if (F.lane == leader) basep = atomicAdd(&CNT[h * 32 + b], (unsigned)n);
                basep = __builtin_amdgcn_readlane(basep, leader);
                if (blk == b) { const unsigned pos = basep + (unsigned)__builtin_popcountll(mask & ((1ull << F.lane) - 1ull)); LIST[(size_t)(h * 32 + b) * 8192 + pos] = (unsigned)q | ((unsigned)s << 16); }
                rem &= ~mask; } }
    }
}

__device__ __forceinline__ void p4_scan(Frame& F, unsigned char* ws) {
    if (F.tid >= 256) return;
    const float* UT = (const float*)(ws + WS_UT); bf16* VS = (bf16*)(ws + WS_VS);
    for (int idx = blockIdx.x * 256 + F.tid; idx < 65536; idx += F.G * 256) { const int h = idx >> 13, e = (idx >> 5) & 255, dch = idx & 31;
        const float lg = __builtin_log2f(1.f - __builtin_exp2f(-5.f - (float)h)); const float gC = __builtin_amdgcn_exp2f(256.f * lg);
        f32x4 s0 = {0.f, 0.f, 0.f, 0.f}, s1 = s0;
#pragma unroll 8
        for (int c = 0; c < 32; ++c) { const size_t z = (size_t)h * 32 + c;
            v4u o; o.x = pk2(s0.x, s0.y); o.y = pk2(s0.z, s0.w); o.z = pk2(s1.x, s1.y); o.w = pk2(s1.z, s1.w);
            *(GAS v4u*)(VS + z * 131072 + (size_t)e * 512 + 256 + dch * 8) = o;
            const GAS f32x4* up = (const GAS f32x4*)(UT + z * 65536 + (size_t)e * 256 + dch * 8);
            s0 = s0 * gC + up[0]; s1 = s1 * gC + up[1]; } }
}

__device__ __forceinline__ unsigned off_b(unsigned row, unsigned ch) { return 256u * row + 16u * (ch ^ (((row & 3u) << 2) | ((row >> 2) & 3u))); }
__device__ __forceinline__ s16x4 vtr(const LAS unsigned char* p) { return __builtin_bit_cast(s16x4, __builtin_amdgcn_ds_read_tr16_b64_v4i16((LAS v4i16_t*)p)); }
__device__ __forceinline__ unsigned cvtpk(float lo, float hi) { unsigned r; asm volatile("v_cvt_pk_bf16_f32 %0, %1, %2" : "=v"(r) : "v"(lo), "v"(hi)); return r; }

struct MobaUnit { int h, kb, nrows, own; const unsigned* list; };
__device__ __forceinline__ MobaUnit moba_decode(const LAS int* pre, const unsigned* CNT, const unsigned* LIST, int NG, int u) {
    MobaUnit U;
    if (u < NG) { int lo = 0, hi = 511;
        while (lo < hi) { const int mid = (lo + hi + 1) >> 1; if (pre[mid] <= u) lo = mid; else hi = mid - 1; }
        const int p = lo, tile = u - pre[p]; const int cnt = (int)__hip_atomic_load(CNT + p, __ATOMIC_RELAXED, __HIP_MEMORY_SCOPE_AGENT);
        U.h = p >> 5; U.kb = p & 31; U.nrows = cnt - tile * 256 < 256 ? cnt - tile * 256 : 256; U.own = 0; U.list = LIST + (size_t)p * 8192 + tile * 256;
    } else { const int v = u - NG; U.h = v >> 5; U.kb = v & 31; U.nrows = 256; U.own = 1; U.list = LIST; }
    return U;
}
__device__ __forceinline__ void moba_stage(Frame& F, const bf16* MK, const bf16* MV, int h, int kb, int hf, LAS unsigned char* buf) {
#pragma unroll
    for (int n = 0; n < 4; ++n) { const int piece = F.wave + 8 * n, row = piece * 4 + (F.lane >> 4), ch = (F.lane & 15) ^ (((row & 3) << 2) | ((row >> 2) & 3));
        const size_t g = (size_t)(kb * 256 + hf * 128 + row) * 2048 + h * 128 + ch * 8;
        __builtin_amdgcn_global_load_lds((const unsigned*)(MK + g), (LAS unsigned*)(buf + piece * 1024), 16, 0, 0);
        __builtin_amdgcn_global_load_lds((const unsigned*)(MV + g), (LAS unsigned*)(buf + 32768 + piece * 1024), 16, 0, 0); }
}
__device__ __forceinline__ void moba_btab(Frame& F, const float* TB, int h, LAS float* bt) {
    if (F.tid < 384) bt[F.tid] = F.tid < 255 ? -__builtin_inff() : TB[h * 132 + (F.tid - 255)];
}

__device__ __forceinline__ void p4_moba(Frame& F, unsigned char* ws) {
    const unsigned* CNT = (const unsigned*)(ws + WS_CTL) + CW_CNT; const unsigned* LIST = (const unsigned*)(ws + WS_LIST);
    const bf16* MQ = (const bf16*)(ws + WS_PROJ); const bf16* MK = MQ + PROJ_STRIDE; const bf16* MV = MK + PROJ_STRIDE;
    bf16* PART = (bf16*)(ws + WS_PART); float* ML = (float*)(ws + WS_ML); const float* TB = (const float*)(ws + TAB_BIAS);
    LAS int* pre = (LAS int*)(F.lds + 140000);
    LAS float* btab0 = (LAS float*)(F.lds + 131072);
    const int lane = F.lane, r32 = lane & 31, hh = lane >> 5;
    __syncthreads();
    if (F.tid < 64) {
        int c8[8], s = 0;
#pragma unroll
        for (int k = 0; k < 8; ++k) { c8[k] = (int)((__hip_atomic_load(CNT + F.lane * 8 + k, __ATOMIC_RELAXED, __HIP_MEMORY_SCOPE_AGENT) + 255u) >> 8); s += c8[k]; }
        int inc = s;
#pragma unroll
        for (int o = 1; o < 64; o <<= 1) { const int t = __shfl_up(inc, o); if (F.lane >= o) inc += t; }
        int run = inc - s;
#pragma unroll
        for (int k = 0; k < 8; ++k) { pre[F.lane * 8 + k] = run; run += c8[k]; }
        if (F.lane == 63) pre[512] = run;
    }
    LDS_WAIT(); __syncthreads();
    const int NG = pre[512], NU = NG + 512;
    const int vcu = (F.G % 8 == 0) ? ((int)blockIdx.x % 8) * (F.G / 8) + (int)blockIdx.x / 8 : (int)blockIdx.x;
    if (vcu >= NU) return;
    const int nun = (NU - vcu + F.G - 1) / F.G;
    LAS int* utab = (LAS int*)(F.lds + 144000);
    if (F.tid < nun && F.tid < 32) { const MobaUnit T = moba_decode(pre, CNT, LIST, NG, vcu + F.tid * F.G);
        utab[F.tid * 5 + 0] = T.h; utab[F.tid * 5 + 1] = T.kb; utab[F.tid * 5 + 2] = T.nrows; utab[F.tid * 5 + 3] = T.own; utab[F.tid * 5 + 4] = (int)(T.list - LIST); }
    LDS_WAIT(); __syncthreads();
#define UTAB(k) MobaUnit{utab[(k) * 5 + 0], utab[(k) * 5 + 1], utab[(k) * 5 + 2], utab[(k) * 5 + 3], LIST + utab[(k) * 5 + 4]}
    unsigned kaddr[8];
#pragma unroll
    for (int s = 0; s < 8; ++s) kaddr[s] = off_b((unsigned)r32, (unsigned)(2 * s + hh));
    unsigned vaddr[4][2];
    { const unsigned blk = (lane >> 4) & 1, q4 = (lane & 15) >> 2, p = lane & 3;
#pragma unroll
      for (int c = 0; c < 4; ++c)
#pragma unroll
          for (int t = 0; t < 2; ++t) vaddr[c][t] = off_b(8u * t + 4u * hh + q4, 4u * c + 2u * blk + (p >> 1)) + 8u * (p & 1); }
    MobaUnit U = UTAB(0);
    moba_stage(F, MK, MV, U.h, U.kb, 0, F.lds);
    moba_btab(F, TB, U.h, btab0);
    const int rix = F.wave * 32 + r32;
    unsigned ent = (!U.own && rix < U.nrows) ? U.list[rix] : 8191u;
    int qpos_n = U.own ? U.kb * 256 + rix : (int)(ent & 0xffffu), slot_n = U.own ? 3 : (int)(ent >> 16);
    bf16x8 qn[8];
#pragma unroll
    for (int s = 0; s < 8; ++s) qn[s] = *(const GAS bf16x8*)(MQ + (size_t)qpos_n * 2048 + U.h * 128 + 16 * s + 8 * hh);
    MobaUnit Un = U;
    bf16x8 qf[8]; f32x16 o[4]; float m = -1e30f, l = 0.f; int qpos = 0, slot = 0; bool valid = false, far = false;
    for (int i = 0; i < nun; ++i) {
        const LAS float* btab = btab0 + (i & 1) * 384;
#pragma unroll
        for (int hf = 0; hf < 2; ++hf) {
            LAS unsigned char* buf = F.lds + hf * 65536;
            VM_WAIT(); LDS_WAIT(); __syncthreads();
            if (hf == 0) {
                valid = rix < U.nrows; qpos = qpos_n; slot = slot_n;
#pragma unroll
                for (int s = 0; s < 8; ++s) qf[s] = qn[s];
                if (i + 1 < nun) { Un = UTAB(i + 1); ent = (!Un.own && rix < Un.nrows) ? Un.list[rix] : 8191u; }
                moba_stage(F, MK, MV, U.h, U.kb, 1, F.lds + 65536);
                far = __all(qpos - (U.kb * 256 + 255) >= 113) != 0;
                m = -1e30f; l = 0.f;
#pragma unroll
                for (int c = 0; c < 4; ++c)
#pragma unroll
                    for (int r = 0; r < 16; ++r) o[c][r] = 0.f;
            } else if (i + 1 < nun) {
                qpos_n = Un.own ? Un.kb * 256 + rix : (int)(ent & 0xffffu); slot_n = Un.own ? 3 : (int)(ent >> 16);
#pragma unroll
                for (int s = 0; s < 8; ++s) qn[s] = *(const GAS bf16x8*)(MQ + (size_t)qpos_n * 2048 + Un.h * 128 + 16 * s + 8 * hh);
                moba_stage(F, MK, MV, Un.h, Un.kb, 0, F.lds);
                moba_btab(F, TB, Un.h, btab0 + ((i + 1) & 1) * 384);
            }
            const int kbase = U.kb * 256;
#pragma unroll
            for (int lc = 0; lc < 2; ++lc) {
                const int kc = 2 * hf + lc;
                if (U.own && kc > (F.wave >> 1)) continue;
                f32x16 p0, p1;
#pragma unroll
                for (int r = 0; r < 16; ++r) { p0[r] = 0.f; p1[r] = 0.f; }
                const LAS unsigned char* Kc = buf + lc * 16384;
                { bf16x8 ka[8], kb2[8];
#pragma unroll
                  for (int s = 0; s < 8; ++s) ka[s] = *(const LAS bf16x8*)(Kc + kaddr[s]);
#pragma unroll
                  for (int s = 0; s < 8; ++s) kb2[s] = *(const LAS bf16x8*)(Kc + 8192 + kaddr[s]);
#pragma unroll
                  for (int s = 0; s < 8; ++s) p0 = __builtin_amdgcn_mfma_f32_32x32x16_bf16(ka[s], qf[s], p0, 0, 0, 0);
#pragma unroll
                  for (int s = 0; s < 8; ++s) p1 = __builtin_amdgcn_mfma_f32_32x32x16_bf16(kb2[s], qf[s], p1, 0, 0, 0);
                  __builtin_amdgcn_sched_group_barrier(0x100, 8, 0);
#pragma unroll
                  for (int q = 0; q < 8; ++q) { __builtin_amdgcn_sched_group_barrier(0x008, 1, 0); __builtin_amdgcn_sched_group_barrier(0x100, 1, 0); }
                  __builtin_amdgcn_sched_group_barrier(0x008, 8, 0); }
                if (!far) {
                    asm volatile("" ::: "memory");
                    const int dq = qpos - (kbase + kc * 64 + 4 * hh) + 255;
#pragma unroll
                    for (int r = 0; r < 16; ++r) { const int cr = (r & 3) + 8 * (r >> 2); int i0 = dq - cr, i1 = i0 - 32;
                        i0 = i0 > 383 ? 383 : i0; i1 = i1 > 383 ? 383 : i1; i0 = i0 < 0 ? 0 : i0; i1 = i1 < 0 ? 0 : i1;
                        p0[r] += btab[i0]; p1[r] += btab[i1]; } }
                float pmax = p0[0];
#pragma unroll
                for (int r = 1; r < 16; ++r) pmax = fmaxf(pmax, p0[r]);
#pragma unroll
                for (int r = 0; r < 16; ++r) pmax = fmaxf(pmax, p1[r]);
                pmax = fmaxf(pmax, __shfl_xor(pmax, 32));
                if (!__all(pmax - m <= 8.f)) { const float mn = fmaxf(m, pmax); const float alpha = __builtin_amdgcn_exp2f(m - mn); m = mn; l *= alpha;
#pragma unroll
                    for (int c = 0; c < 4; ++c)
#pragma unroll
                        for (int r = 0; r < 16; ++r) o[c][r] *= alpha; }
                float ls = 0.f;
#pragma unroll
                for (int r = 0; r < 16; ++r) { p0[r] = __builtin_amdgcn_exp2f(p0[r] - m); p1[r] = __builtin_amdgcn_exp2f(p1[r] - m); ls += p0[r] + p1[r]; }
                l += ls;
                const LAS unsigned char* Vc = buf + 32768 + lc * 16384;
                { v4u pw[4];
                  pw[0].x = cvtpk(p0[0], p0[1]); pw[0].y = cvtpk(p0[2], p0[3]); pw[0].z = cvtpk(p0[4], p0[5]); pw[0].w = cvtpk(p0[6], p0[7]);
                  pw[1].x = cvtpk(p0[8], p0[9]); pw[1].y = cvtpk(p0[10], p0[11]); pw[1].z = cvtpk(p0[12], p0[13]); pw[1].w = cvtpk(p0[14], p0[15]);
                  pw[2].x = cvtpk(p1[0], p1[1]); pw[2].y = cvtpk(p1[2], p1[3]); pw[2].z = cvtpk(p1[4], p1[5]); pw[2].w = cvtpk(p1[6], p1[7]);
                  pw[3].x = cvtpk(p1[8], p1[9]); pw[3].y = cvtpk(p1[10], p1[11]); pw[3].z = cvtpk(p1[12], p1[13]); pw[3].w = cvtpk(p1[14], p1[15]);
#pragma unroll
                  for (int ss = 0; ss < 4; ++ss) {
                      const bf16x8 pb = __builtin_bit_cast(bf16x8, pw[ss]);
#pragma unroll
                      for (int c = 0; c < 4; ++c) { const s16x4 lo = vtr(Vc + ss * 4096 + vaddr[c][0]), hi = vtr(Vc + ss * 4096 + vaddr[c][1]);
                          const bf16x8 va = __builtin_shufflevector(lo, hi, 0, 1, 2, 3, 4, 5, 6, 7);
                          o[c] = __builtin_amdgcn_mfma_f32_32x32x16_bf16(va, pb, o[c], 0, 0, 0); } }
                  __builtin_amdgcn_sched_group_barrier(0x100, 8, 0);
#pragma unroll
                  for (int q = 0; q < 12; ++q) { __builtin_amdgcn_sched_group_barrier(0x008, 1, 0); __builtin_amdgcn_sched_group_barrier(0x100, 2, 0); }
                  __builtin_amdgcn_sched_group_barrier(0x008, 4, 0); }
            }
            if (hf == 1) {
                l += __shfl_xor(l, 32);
                if (far) m += btab[383];
                if (valid) {
                    const float il = 1.f / l; const size_t pbase = (((size_t)qpos * 16 + U.h) * 4 + slot);
                    bf16* po = PART + pbase * 128;
#pragma unroll
                    for (int c = 0; c < 4; ++c)
#pragma unroll
                        for (int g = 0; g < 4; ++g) { v2u w; w.x = pk2(o[c][4 * g] * il, o[c][4 * g + 1] * il); w.y = pk2(o[c][4 * g + 2] * il, o[c][4 * g + 3] * il);
                            *(GAS v2u*)(po + 32 * c + 8 * g + 4 * hh) = w; }
                    if (hh == 0) *(GAS f32x2*)(ML + pbase * 2) = (f32x2){m, l};
                }
                U = Un;
            }
        }
    }
#undef UTAB
}

__device__ __forceinline__ void p5_combine(Frame& F, unsigned char* ws) {
    const bf16* PART = (const bf16*)(ws + WS_PART); const float* ML = (const float*)(ws + WS_ML); bf16* MIX = (bf16*)(ws + WS_MIX);
    const int l16 = F.lane & 15, sub = F.lane >> 4;
    for (int pi0 = F.gw * 4 + sub; pi0 < T_ * 16; pi0 += F.NGW * 8) {
        f32x2 ml[2][4]; v4u pv[2][4]; int nv[2];
#pragma unroll
        for (int u = 0; u < 2; ++u) { const int pi = pi0 + u * F.NGW * 4; const int q = pi >> 4; nv[u] = (q >> 8) < 3 ? (q >> 8) : 3; const size_t pb = (size_t)pi * 4;
#pragma unroll
            for (int s = 0; s < 4; ++s) { const bool on = pi < T_ * 16 && ((s == 3) || (s < nv[u]));
                ml[u][s] = on ? *(const GAS f32x2*)(ML + (pb + s) * 2) : (f32x2){-1e30f, 0.f};
                pv[u][s] = on ? *(const GAS v4u*)(PART + (pb + s) * 128 + l16 * 8) : (v4u){0u, 0u, 0u, 0u}; } }
#pragma unroll
        for (int u = 0; u < 2; ++u) { const int pi = pi0 + u * F.NGW * 4; if (pi >= T_ * 16) continue; const int q = pi >> 4, h = pi & 15;
            float M = fmaxf(fmaxf(ml[u][0].x, ml[u][1].x), fmaxf(ml[u][2].x, ml[u][3].x));
            float acc[8] = {0.f, 0.f, 0.f, 0.f, 0.f, 0.f, 0.f, 0.f}; float W = 0.f;
#pragma unroll
            for (int s = 0; s < 4; ++s) { const float w = __builtin_amdgcn_exp2f(ml[u][s].x - M) * ml[u][s].y; W += w; float f[8]; unpack8(pv[u][s], f);
#pragma unroll
                for (int e = 0; e < 8; ++e) acc[e] += w * f[e]; }
            const float iw = 1.f / W;
#pragma unroll
            for (int e = 0; e < 8; ++e) acc[e] *= iw;
            *(GAS v4u*)(MIX + (size_t)q * 4096 + h * 128 + l16 * 8) = pack8(acc); } }
}

__device__ __forceinline__ unsigned f2ord(float f) { const unsigned u = __builtin_bit_cast(unsigned, f); return (u & 0x80000000u) ? ~u : (u | 0x80000000u); }
__device__ __forceinline__ float ord2f(unsigned o) { return __builtin_bit_cast(float, (o & 0x80000000u) ? (o ^ 0x80000000u) : ~o); }
#define CEX(a, b) do { const unsigned _hi = (a) > (b) ? (a) : (b); const unsigned _lo = (a) > (b) ? (b) : (a); (a) = _hi; (b) = _lo; } while (0)
__device__ __forceinline__ void bitonic_merge16(unsigned (&a)[16]) {
#pragma unroll
    for (int j = 8; j > 0; j >>= 1)
#pragma unroll
        for (int i = 0; i < 16; ++i) if ((i & j) == 0) CEX(a[i], a[i | j]);
}
__device__ __forceinline__ void sort16_desc(unsigned (&a)[16]) {
#pragma unroll
    for (int k = 2; k <= 16; k <<= 1)
#pragma unroll
        for (int j = k >> 1; j > 0; j >>= 1)
#pragma unroll
            for (int i = 0; i < 16; ++i) { const int l = i ^ j; if (l > i) { if ((i & k) == 0 || k == 16) { CEX(a[i], a[l]); } else { CEX(a[l], a[i]); } } }
}
__device__ __forceinline__ void merge_top16(unsigned (&L)[16], const unsigned (&G)[16]) {
#pragma unroll
    for (int i = 0; i < 16; ++i) L[i] = L[i] > G[15 - i] ? L[i] : G[15 - i];
    bitonic_merge16(L);
}

template <int MODE> __device__ __forceinline__ void p9_peer_route(Frame& F, unsigned char* ws) {
    const bf16* PQP = (const bf16*)(ws + WS_PQP); const bf16* KEYS = (const bf16*)(ws + TAB_KEYS); bf16* GW = (bf16*)(ws + WS_GW); unsigned* BM = (unsigned*)(ws + WS_BM);
    LAS unsigned* LE = (LAS unsigned*)F.lds; LAS float* LG = (LAS float*)(F.lds + 8192);
    LAS unsigned* HVAL = (LAS unsigned*)(F.lds + 16384);
    LAS unsigned* HKEY = (LAS unsigned*)(F.lds + 81920);
    LAS unsigned* BMl = (LAS unsigned*)(F.lds + 98304);
    LAS unsigned* ABL = (LAS unsigned*)(F.lds + 102400);
    const int lane = F.lane, w = F.wave, tk = lane & 15, q = lane >> 4;
    for (int unit = blockIdx.x; unit < T_ / 16; unit += F.G) {
        const int t0 = unit * 16;
        __syncthreads();
        { const v4u z = {0u, 0u, 0u, 0u}, ff = {0xffffffffu, 0xffffffffu, 0xffffffffu, 0xffffffffu};
          for (int i = F.tid; i < 65536 / 16; i += 512) *(LAS v4u*)((LAS unsigned char*)HVAL + i * 16) = z;
          for (int i = F.tid; i < 16384 / 16; i += 512) *(LAS v4u*)((LAS unsigned char*)HKEY + i * 16) = ff;
          if (F.tid < 256) *(LAS v4u*)((LAS unsigned char*)BMl + F.tid * 16) = z; }
        unsigned AB[2][16];
#pragma unroll
        for (int c = 0; c < 2; ++c) {
            bf16x8 af[4];
#pragma unroll
            for (int ks = 0; ks < 4; ++ks) af[ks] = *(const GAS bf16x8*)(PQP + (size_t)(t0 + tk) * 2048 + w * 256 + c * 128 + 32 * ks + 8 * q);
            unsigned kk[2][16];
#pragma unroll
            for (int nt = 0; nt < 8; ++nt) { f32x4 acc = {0.f, 0.f, 0.f, 0.f};
#pragma unroll
                for (int ks = 0; ks < 4; ++ks) { const bf16x8 kf = *(const GAS bf16x8*)(KEYS + (size_t)((w * 2 + c) * 128 + 16 * nt + tk) * 128 + 32 * ks + 8 * q);
                    acc = __builtin_amdgcn_mfma_f32_16x16x32_bf16(kf, af[ks], acc, 0, 0, 0); }
#pragma unroll
                for (int r = 0; r < 4; ++r) kk[nt >> 2][(nt & 3) * 4 + r] = (f2ord(acc[r]) & 0xffffff80u) | (unsigned)(16 * nt + 4 * q + r); }
            sort16_desc(kk[0]); sort16_desc(kk[1]); merge_top16(kk[0], kk[1]);
            unsigned G[16];
#pragma unroll
            for (int i = 0; i < 16; ++i) G[i] = (unsigned)__shfl_xor((int)kk[0][i], 16);
            merge_top16(kk[0], G);
#pragma unroll
            for (int i = 0; i < 16; ++i) G[i] = (unsigned)__shfl_xor((int)kk[0][i], 32);
            merge_top16(kk[0], G);
#pragma unroll
            for (int i = 0; i < 16; ++i) AB[c][i] = kk[0][i];
        }
        if (q == 0) {
#pragma unroll
            for (int i = 0; i < 4; ++i) { *(LAS v4u*)(ABL + (w * 16 + tk) * 32 + 4 * i) = (v4u){AB[0][4 * i], AB[0][4 * i + 1], AB[0][4 * i + 2], AB[0][4 * i + 3]};
                *(LAS v4u*)(ABL + (w * 16 + tk) * 32 + 16 + 4 * i) = (v4u){AB[1][4 * i], AB[1][4 * i + 1], AB[1][4 * i + 2], AB[1][4 * i + 3]}; } }
        if constexpr (MODE != 3) {
        unsigned M[16];
#pragma unroll
        for (int i = 0; i < 16; ++i) M[i] = 0u;
        { float av[16], bv[16];
#pragma unroll
          for (int i = 0; i < 16; ++i) { av[i] = ord2f(AB[0][i] & 0xffffff80u); bv[i] = ord2f(AB[1][i] & 0xffffff80u); }
          unsigned cd[16]; int nc = 0;
#pragma unroll
          for (int i = 0; i < 16; ++i)
#pragma unroll
              for (int j = 0; j < 16; ++j) if ((i + 1) * (j + 1) <= 16) {
                  cd[nc & 15] = (f2ord(av[i] + bv[j]) & 0xffffff00u) | (unsigned)(i * 16 + j); ++nc;
                  if ((nc & 15) == 0) { sort16_desc(cd); if (nc == 16) {
#pragma unroll
                      for (int x = 0; x < 16; ++x) M[x] = cd[x]; } else merge_top16(M, cd); } }
#pragma unroll
          for (int x = 2; x < 16; ++x) cd[x] = 0u;
          sort16_desc(cd); merge_top16(M, cd); }
        LDS_WAIT(); __builtin_amdgcn_wave_barrier();
        { float sc[16]; float mx = -__builtin_inff();
#pragma unroll
          for (int k = 0; k < 16; ++k) { sc[k] = ord2f(M[k] & 0xffffff00u); mx = fmaxf(mx, sc[k]); }
          float sum = 0.f;
#pragma unroll
          for (int k = 0; k < 16; ++k) { sc[k] = __builtin_amdgcn_exp2f((sc[k] - mx) * LOG2E); sum += sc[k]; }
          const float is = 1.f / sum;
#pragma unroll
          for (int k = 0; k < 16; ++k) if ((k >> 2) == q) { const unsigned id = M[k] & 255u, i = id >> 4, j = id & 15u;
              const unsigned ea = ABL[(w * 16 + tk) * 32 + i] & 127u, eb = ABL[(w * 16 + tk) * 32 + 16 + j] & 127u;
              LE[tk * 128 + w * 16 + k] = ea * 128u + eb; LG[tk * 128 + w * 16 + k] = sc[k] * is; } }
        } else { if (AB[0][0] == 0x12345u && AB[1][5] == 7u) LE[tk] = AB[0][3]; }
        LDS_WAIT(); __syncthreads();
        if constexpr (MODE <= 1) {
#pragma unroll
        for (int k = 0; k < 4; ++k) { const int pidx = F.tid + 512 * k, tok = pidx >> 7; const unsigned e = LE[pidx]; const float g = LG[pidx]; const unsigned ch = e >> 3;
            unsigned hs = (ch * 0x9E3779B1u) >> 24;
            for (;;) { unsigned expect = 0xffffffffu;
                const bool ok = __hip_atomic_compare_exchange_strong(HKEY + tok * 256 + hs, &expect, ch, __ATOMIC_RELAXED, __ATOMIC_RELAXED, __HIP_MEMORY_SCOPE_WORKGROUP);
                if (ok || expect == ch) break; hs = (hs + 1u) & 255u; }
            const unsigned gb = f2bf(g);
            __builtin_amdgcn_ds_atomic_fadd_v2bf16((LAS s16x2*)(HVAL + ((tok * 256 + hs) * 4 + ((e & 7u) >> 1))), __builtin_bit_cast(s16x2, (e & 1u) ? (gb << 16) : gb)); }
        LDS_WAIT(); __syncthreads();
#pragma unroll
        for (int k = 0; k < 8; ++k) { const int sidx = F.tid + 512 * k, tok = sidx >> 8; const unsigned ch = HKEY[sidx];
            if (ch != 0xffffffffu) {
                if constexpr (MODE == 0) *(GAS v4u*)(GW + (size_t)(t0 + tok) * 16384 + ch * 8) = *(const LAS v4u*)(HVAL + sidx * 4);
                __hip_atomic_fetch_or(BMl + tok * 64 + (ch >> 5), 1u << (ch & 31u), __ATOMIC_RELAXED, __HIP_MEMORY_SCOPE_WORKGROUP); } }
        LDS_WAIT(); __syncthreads();
        }
        if constexpr (MODE == 0)
        for (int i = F.tid; i < 1024; i += 512) BM[(size_t)t0 * 64 + i] = BMl[i];
    }
}

__device__ __forceinline__ void p12_final_norm(Frame& F, const Args& args) {
    for (int m = F.gw; m < T_; m += F.NGW) { float* row = args.out + (size_t)m * DM; const GAS f32x4* xr = (const GAS f32x4*)row + F.lane; const GAS f32x4* gr = (const GAS f32x4*)args.in[10] + F.lane;
        f32x4 v[16]; float s = 0.f;
#pragma unroll
        for (int j = 0; j < 16; ++j) { v[j] = xr[64 * j]; s += (v[j].x * v[j].x + v[j].y * v[j].y) + (v[j].z * v[j].z + v[j].w * v[j].w); }
        const float rstd = 1.f / sqrtf(wave_sum(s) * (1.f / DM) + NORM_EPS);
        GAS f32x4* o = (GAS f32x4*)row + F.lane;
#pragma unroll
        for (int j = 0; j < 16; ++j) o[64 * j] = v[j] * rstd * gr[64 * j]; }
}

constexpr int NPH = 13;
__global__ void __launch_bounds__(512, 2) fwd(Args args) {
    extern __shared__ __attribute__((aligned(16))) unsigned char lds_raw[];
    Frame F;
    F.lds = (LAS unsigned char*)lds_raw;
    F.tid = threadIdx.x; F.lane = F.tid & 63; F.wave = __builtin_amdgcn_readfirstlane(F.tid >> 6);
    F.G = gridDim.x; F.gw = blockIdx.x * 8 + F.wave; F.NGW = F.G * 8;
    unsigned char* ws = args.ws;
    volatile LAS unsigned* MISC = (volatile LAS unsigned*)(F.lds + MISC_OFF);
    for (int u = F.tid; u < (LDS_BYTES - LDSCTL_OFF) / 4; u += 512) ((LAS unsigned*)(F.lds + LDSCTL_OFF))[u] = 0u;
    __syncthreads();
    XcdBarrier bar = xcd_barrier_post((unsigned*)(ws + WS_CTL) + CW_BAR, MISC + 8);
    const int lo = args.ph_lo, hi = args.ph_hi;
#ifndef PHMASK
#define PHMASK 0xffff
#endif
#define IN(k) (((PHMASK >> (k)) & 1) && lo <= (k) && (k) < hi)
#define SEAM(k) do { if (IN(k) && IN((k) + 1)) xcd_barrier(bar); } while (0)
#ifndef PHDUP
#define PHDUP 0
#endif
#define DUPQ(k) (((PHDUP >> (k)) & 1) != 0)
    bf16* XN = (bf16*)(ws + WS_XN); bf16* MIX = (bf16*)(ws + WS_MIX); float* H1 = (float*)(ws + WS_H1);

#define PHASE(k, ...) if (IN(k)) { { __VA_ARGS__ } if (DUPQ(k)) { xcd_barrier(bar); { __VA_ARGS__ } } } SEAM(k);
    PHASE(0, p0_prologue(F, args);)
    PHASE(1,
        { pg8::Gemm g{(const bf16*)(ws + WS_XN8), (const bf16*)(ws + WS_WIN8), DM / 2, DM / 2, DM / 2, 0, 0}; pg8::StaticOrder S; S.init(T_, 3 * MW, F.G, (int)blockIdx.x);
          pg8::EpiBf16<0> E{(bf16*)(ws + WS_PROJ), 2048, nullptr, 2048, PROJ_STRIDE, QSCALE, 1.f / (XN8_SCALE * WIN8_SCALE)};
          pg8::gemm_phase<pg8::EpiBf16<0>, pg8::StaticOrder, true, true, 1>(F.lds, g, S, E); }
        { pg8::Gemm g{XN, (const bf16*)(ws + WS_WINB), DM, DM, DM, 0, 0}; pg8::StaticOrder S; S.init(T_, INW - 3 * MW, F.G, (int)blockIdx.x);
          pg8::EpiBf16<0> E{(bf16*)(ws + WS_PROJ) + 3 * PROJ_STRIDE, 2048, nullptr, 2048, PROJ_STRIDE, 1.f, 1.f};
          pg8::gemm_phase<pg8::EpiBf16<0>, pg8::StaticOrder, true, true>(F.lds, g, S, E); })
    if (IN(2)) { p2_prep<false>(F, ws); if (DUPQ(2)) { xcd_barrier(bar); p2_prep<true>(F, ws); } } SEAM(2);
#ifndef P3SUB
#define P3SUB 7
#endif
#define P3_PGEMM { pg8::Gemm g{(const bf16*)(ws + WS_PROJ) + 3 * PROJ_STRIDE, (const bf16*)(ws + WS_PROJ) + 4 * PROJ_STRIDE, 2048, 2048, 256, 256, 256}; \
          pg8::HOrder S{F.G, (int)blockIdx.x}; pg8::EpiRetP E{(bf16*)(ws + WS_PQ)}; \
          pg8::gemm_phase<pg8::EpiRetP, pg8::HOrder, false, true>(F.lds, g, S, E); }
#define P3_UTGEMM { pg8::Gemm g{(const bf16*)(ws + WS_VS), (const bf16*)(ws + WS_KT), 512, 256, 256, 131072, 65536}; pg8::BatchOrder S{256, F.G, (int)blockIdx.x}; \
          pg8::EpiF32Z E{(float*)(ws + WS_UT)}; \
          pg8::gemm_phase<pg8::EpiF32Z, pg8::BatchOrder, false, true>(F.lds, g, S, E); }
    if (IN(3)) {
        P3_PGEMM P3_UTGEMM p3_gating<false>(F, ws);
        if (DUPQ(3)) { xcd_barrier(bar); if (P3SUB & 1) P3_PGEMM if (P3SUB & 2) P3_UTGEMM if (P3SUB & 4) p3_gating<true>(F, ws); }
    } SEAM(3);
#ifndef P4SUB
#define P4SUB 3
#endif
    if (IN(4)) { p4_scan(F, ws); p4_moba(F, ws); if (DUPQ(4)) { xcd_barrier(bar); if (P4SUB & 1) p4_scan(F, ws); if (P4SUB & 2) p4_moba(F, ws); } } SEAM(4);
    PHASE(5,
        { pg8::Gemm g{(const bf16*)(ws + WS_PQ), (const bf16*)(ws + WS_VS), 512, 512, 512, 131072, 131072}; pg8::EpiRetOut E{(const bf16*)(ws + WS_PROJ) + 6 * PROJ_STRIDE, MIX};
          pg8::OneOrder O{(int)blockIdx.x};
          pg8::gemm_phase<pg8::EpiRetOut, pg8::OneOrder, false, true>(F.lds, g, O, E); __syncthreads(); }
        p5_combine(F, ws);)
    PHASE(6,
        pg8::Gemm g{MIX, (const bf16*)(ws + WS_WOUT_T), DM, DM, DM, 0, 0}; pg8::StaticOrder S; S.init(T_, DM, F.G, (int)blockIdx.x);
        pg8::EpiResF32 E{args.in[0], H1, DM, 1.f};
        pg8::gemm_phase<pg8::EpiResF32, pg8::StaticOrder, true, true>(F.lds, g, S, E);)
    PHASE(7, for (int m = F.gw; m < T_; m += F.NGW) rms_row_to_bf16<1>(F.lane, H1 + (size_t)m * DM, args.in[5], XN + (size_t)m * DM, ws + WS_TN8 + (size_t)m * DM);)
    PHASE(8,
        pg8::Gemm g{XN, (const bf16*)(ws + WS_WQ_T), DM, DM, DM, 0, 0}; pg8::StaticOrder S; S.init(T_, 2048, F.G, (int)blockIdx.x);
        pg8::EpiBf16<0> E{(bf16*)(ws + WS_PQP), 2048, nullptr, 0, 0, 1.f, 1.f};
        pg8::gemm_phase<pg8::EpiBf16<0>, pg8::StaticOrder, true, true>(F.lds, g, S, E);)
#ifndef P9MODE
#define P9MODE 0
#endif
    if (IN(9)) { p9_peer_route<0>(F, ws); if (DUPQ(9)) { xcd_barrier(bar); p9_peer_route<(P9MODE ? P9MODE : 1)>(F, ws); } } SEAM(9);
#ifndef P10MODE
#define P10MODE 1
#endif
    if (IN(10)) {
        { pg8::Gemm g{(const bf16*)(ws + WS_TN8), (const bf16*)(ws + WS_U8), DM / 2, DM / 2, DM / 2, 0, 0}; pg8::StaticOrder S; S.init(T_, NEXP, F.G, (int)blockIdx.x);
          pg8::EpiPeerW8<0> E{(const bf16*)(ws + WS_GW), (const unsigned*)(ws + WS_BM), ws + WS_W8, 1.f / (TN8_SCALE * U8_SCALE), W8_SCALE};
          pg8::gemm_phase<pg8::EpiPeerW8<0>, pg8::StaticOrder, true, true, 1>(F.lds, g, S, E); }
        if (DUPQ(10)) { xcd_barrier(bar);
          pg8::Gemm g{(const bf16*)(ws + WS_TN8), (const bf16*)(ws + WS_U8), DM / 2, DM / 2, DM / 2, 0, 0}; pg8::StaticOrder S; S.init(T_, NEXP, F.G, (int)blockIdx.x);
          pg8::EpiPeerW8<P10MODE> E{(const bf16*)(ws + WS_GW), (const unsigned*)(ws + WS_BM), ws + WS_GW, 1.f / (TN8_SCALE * U8_SCALE), W8_SCALE};
          pg8::gemm_phase<pg8::EpiPeerW8<P10MODE>, pg8::StaticOrder, true, true, 1>(F.lds, g, S, E); }
    } SEAM(10);
    PHASE(11,
        pg8::Gemm g{(const bf16*)(ws + WS_W8), (const bf16*)(ws + WS_V8T), NEXP / 2, NEXP / 2, NEXP / 2, 0, 0}; pg8::StaticOrder S; S.init(T_, DM, F.G, (int)blockIdx.x);
        pg8::EpiResF32 E{H1, args.out, DM, 1.f / (W8_SCALE * V8_SCALE)};
        pg8::gemm_phase<pg8::EpiResF32, pg8::StaticOrder, true, true, 1>(F.lds, g, S, E);)
#ifdef F6PROBE
    if (IN(11)) { xcd_barrier(bar);
        { pg8::Gemm g{(const bf16*)(ws + WS_W8), (const bf16*)(ws + WS_V8T), NEXP / 2, NEXP / 2, NEXP / 2, 0, 0}; pg8::StaticOrder S; S.init(T_, DM, F.G, (int)blockIdx.x);
          pg8::EpiResF32 E{H1, (float*)(ws + WS_GW), DM, 1.f};
          pg8::gemm_phase<pg8::EpiResF32, pg8::StaticOrder, true, true, 2>(F.lds, g, S, E); }
        xcd_barrier(bar); }
#endif
    if (IN(12)) p12_final_norm(F, args);
#undef PHASE
#undef IN
#undef SEAM
}

extern "C" void kernel_launch(void* const* d_in, const int* in_sizes, int n_in, void* d_out, int out_size, void* d_ws, size_t ws_size, hipStream_t stream) {
    static int grid = 0;
    if (grid == 0) {
        if (n_in != 11 || ws_size < WS_END) { fprintf(stderr, "kernel_launch: built for 11 inputs and >= %zu bytes of workspace; got n_in %d, ws %zu\n", (size_t)WS_END, n_in, ws_size); grid = -1; return; }
        int dev = 0, cus = 0, per_cu = 0;
        if (hipGetDevice(&dev) != hipSuccess || hipDeviceGetAttribute(&cus, hipDeviceAttributeMultiprocessorCount, dev) != hipSuccess) { grid = -1; return; }
        if (hipFuncSetAttribute((const void*)fwd, hipFuncAttributeMaxDynamicSharedMemorySize, LDS_BYTES) != hipSuccess) { fprintf(stderr, "kernel_launch: hipFuncSetAttribute failed\n"); grid = -1; return; }
        if (hipOccupancyMaxActiveBlocksPerMultiprocessor(&per_cu, (const void*)fwd, 512, LDS_BYTES) != hipSuccess || per_cu < 1) fprintf(stderr, "kernel_launch: occupancy query reports %d\n", per_cu);
        (void)hipGetLastError();
        grid = cus;
    }
    if (grid < 0) return;
    if (hipMemsetAsync((char*)d_ws + WS_CTL, 0, CTL_ZERO_BYTES, stream) != hipSuccess) return;
    Args a{};
    for (int i = 0; i < 11; ++i) a.in[i] = (const float*)d_in[i];
    a.out = (float*)d_out; a.ws = (unsigned char*)d_ws;
#if MK_ONE_LAUNCH
    a.ph_lo = 0; a.ph_hi = NPH;
    hipLaunchKernelGGL(fwd, dim3(grid), dim3(512), LDS_BYTES, stream, a);
#else
    for (int p = 0; p < NPH; ++p) { a.ph_lo = p; a.ph_hi = p + 1; hipLaunchKernelGGL(fwd, dim3(grid), dim3(512), LDS_BYTES, stream, a); }
#endif
}
```

```cpp
#include <hip/hip_runtime.h>
#include <cstdio>
#include <cstdint>

#ifndef MK_ONE_LAUNCH
#define MK_ONE_LAUNCH 1
#endif

namespace pg8 {
#define PG8_LAS __attribute__((address_space(3)))
typedef unsigned short bf16_t;
typedef short bf16x8 __attribute__((ext_vector_type(8)));
typedef float f32x4 __attribute__((ext_vector_type(4)));
typedef unsigned u32x4 __attribute__((ext_vector_type(4)));
constexpr int BM = 256, BK = 64, HALF = 128, HTB = HALF * BK * 2  , STAGE_BYTES = 8 * HTB, NXCD = 8, WGM = 8;

__host__ __device__ __forceinline__ int lds_byte(int r, int c) { const int st = (r >> 4) * 2 + (c >> 5), rr = r & 15, cc = c & 31, ob = rr * 64 + cc * 2; return st * 1024 + (ob ^ (((ob >> 9) & 1) << 5)); }
__host__ __device__ __forceinline__ void stage_rc(int b, int& R, int& C) { const int st = b / 1024, sb = b % 1024, swz = sb ^ (((sb >> 9) & 1) << 5); R = (st >> 1) * 16 + swz / 64; C = (st & 1) * 32 + (swz % 64) / 2; }
__host__ __device__ __forceinline__ int perm32(int rho) { const int n = rho >> 4, i = rho & 15; return 8 * (i >> 2) + 4 * n + (i & 3); }

typedef int v4i_t __attribute__((ext_vector_type(4)));
typedef int v8i_t __attribute__((ext_vector_type(8)));
typedef int v6i_t __attribute__((ext_vector_type(6)));
__device__ __forceinline__ v6i_t lo6(v8i_t v) { return __builtin_shufflevector(v, v, 0, 1, 2, 3, 4, 5); }
__device__ __forceinline__ v8i_t ld8(const PG8_LAS unsigned char* p) { const v4i_t a = *(const PG8_LAS v4i_t*)p, b = *(const PG8_LAS v4i_t*)(p + 1024); return __builtin_shufflevector(a, b, 0, 1, 2, 3, 4, 5, 6, 7); }
template <class...> struct pg8_void { typedef void type; };
template <class E, class = void> struct epi_state { struct type {}; static constexpr bool has = false; };
template <class E> struct epi_state<E, typename pg8_void<typename E::State>::type> { typedef typename E::State type; static constexpr bool has = true; };
struct Unit { int pm, pn, z; };
struct Gemm { const bf16_t* A; const bf16_t* Bt; int lda, ldb, K; long sAz, sBz; };

struct StaticOrder {
    int nM, nN, nwg, G, c;
    __host__ __device__ void init(int M, int N, int G_, int c_) { nM = M / BM; nN = N / BM; nwg = nM * nN; G = G_; c = c_; }
    __host__ __device__ bool next(int i, Unit& u) const {
        const long L = (long)i * G + c; if (L >= nwg) return false;
        int wgid = (int)L; { const int q = nwg / NXCD, r = nwg % NXCD, xcd = wgid % NXCD, off = wgid / NXCD; wgid = (xcd < r ? xcd * (q + 1) : r * (q + 1) + (xcd - r) * q) + off; }
        const int nig = WGM * nN, gid = wgid / nig, fm = gid * WGM, gsz = (nM - fm) < WGM ? (nM - fm) : WGM;
        u.pm = fm + ((wgid % nig) % gsz); u.pn = (wgid % nig) / gsz; u.z = 0; return true;
    }
    __device__ __forceinline__ void a_ready(const Unit&) const {}
    __device__ __forceinline__ void done(const Unit&) const {}
};

__device__ __forceinline__ unsigned cvt_pk_bf16(float lo, float hi) { unsigned r; asm volatile("v_cvt_pk_bf16_f32 %0, %1, %2" : "=v"(r) : "v"(lo), "v"(hi)); return r; }
typedef float f32x2 __attribute__((ext_vector_type(2)));
__device__ __forceinline__ f32x2 gelu_pk(f32x2 v) {
    const f32x2 av = __builtin_elementwise_abs(v), d = av * 0.2316418882f + 1.0f;
    f32x2 t; t.x = __builtin_amdgcn_rcpf(d.x); t.y = __builtin_amdgcn_rcpf(d.y);
    f32x2 q = t * 0.5307027145f + (-0.7265760135f); q = q * t + 0.7107068705f; q = q * t + (-0.142248368f); q = q * t + 0.127414796f; q = q * t;
    const f32x2 s = (v * v) * (-0.72134752044f);
    f32x2 e; e.x = __builtin_amdgcn_exp2f(s.x); e.y = __builtin_amdgcn_exp2f(s.y);
    const f32x2 m = v * (q * e), r = v - m;
    f32x2 o; o.x = v.x < 0.f ? m.x : r.x; o.y = v.y < 0.f ? m.y : r.y; return o;
}

template <int ACT  > struct EpiBf16 {
    static constexpr bool PERM = true, AFTER_DRAIN = false; static_assert(ACT == 0 || ACT == 1, "EpiBf16: ACT is 0 (none) or 1 (gelu_pk)");
    bf16_t* O; int ldc; const float* bias; int split_cols; size_t split_stride; float scale0, gs;
    __device__ __forceinline__ void operator()(const f32x4 (&acc)[2][2][4][2], const Unit& u, int wr, int wc, int fr, int fq) const {
        const int row0 = u.pm * BM + wr * 64 + fr; int colt = u.pn * BM; bf16_t* base = O;
        float sc = gs; if (split_cols) { const int t = colt / split_cols; base += (size_t)t * split_stride; colt -= t * split_cols; if (t == 0) sc = scale0 * gs; }
        const int col0 = colt + wc * 32 + 8 * fq, bcol0 = u.pn * BM + wc * 32 + 8 * fq;
        f32x4 bv[2][2];
#pragma unroll
        for (int bj = 0; bj < 2; ++bj)
#pragma unroll
            for (int n = 0; n < 2; ++n) bv[bj][n] = bias ? *(const f32x4*)(bias + bcol0 + bj * HALF + 4 * n) : (f32x4){0.f, 0.f, 0.f, 0.f};
#pragma unroll
        for (int ai = 0; ai < 2; ++ai)
#pragma unroll
            for (int m = 0; m < 4; ++m) { bf16_t* rowp = base + (size_t)(row0 + ai * HALF + m * 16) * ldc + col0;
#pragma unroll
                for (int bj = 0; bj < 2; ++bj) { f32x4 v0 = acc[ai][bj][m][0] + bv[bj][0], v1 = acc[ai][bj][m][1] + bv[bj][1];
                    if (ACT == 1) { f32x2 a = gelu_pk((f32x2){v0[0], v0[1]}), b = gelu_pk((f32x2){v0[2], v0[3]}), c = gelu_pk((f32x2){v1[0], v1[1]}), d = gelu_pk((f32x2){v1[2], v1[3]});
                        v0 = (f32x4){a.x, a.y, b.x, b.y}; v1 = (f32x4){c.x, c.y, d.x, d.y}; }
                    v0 = v0 * sc; v1 = v1 * sc; u32x4 w; w.x = cvt_pk_bf16(v0[0], v0[1]); w.y = cvt_pk_bf16(v0[2], v0[3]); w.z = cvt_pk_bf16(v1[0], v1[1]); w.w = cvt_pk_bf16(v1[2], v1[3]);
                    *(u32x4*)(rowp + bj * HALF) = w; } }
    }
};

template <class Epi, class Sched, bool ALIGN_EPI = false, bool SP2 = false, int F8 = 0>
__device__ __forceinline__ void gemm_phase(PG8_LAS unsigned char* lds, const Gemm g, const Sched& S, const Epi& E) {
    const int tid = threadIdx.x, wid = __builtin_amdgcn_readfirstlane(tid >> 6), lane = tid & 63, wr = wid >> 2, wc = wid & 3, fr = lane & 15, fq = lane >> 4;
    const int K = g.K, nt = K / BK;
    unsigned voffA[2], voffB[2];
#pragma unroll
    for (int i = 0; i < 2; ++i) { int R, C; stage_rc(tid * 16 + i * 8192, R, C); const int Rb = Epi::PERM ? ((R & ~31) + perm32(R & 31)) : R;
        voffA[i] = (unsigned)(R * g.lda + C) * 2u; voffB[i] = (unsigned)(Rb * g.ldb + C) * 2u; }
    const size_t kstep = (size_t)(BK * 2);
    const size_t hstepA = (size_t)HALF * g.lda * 2, hstepB = (size_t)HALF * g.ldb * 2;
    const unsigned ldsw = (unsigned)wid * 1024u;
    const int aoff = lds_byte(wr * 64 + fr, fq * 8), boff = lds_byte(wc * 32 + fr, fq * 8);
#define PG8_SA(b, h) (((b) * 2 + (h)) * HTB)
#define PG8_SB(b, h) ((4 + (b) * 2 + (h)) * HTB)
#define PG8_STAGE(bufoff, gbase, voff) do { _Pragma("unroll") for (int _i = 0; _i < 2; ++_i) \
        __builtin_amdgcn_global_load_lds((const unsigned*)((const char*)(gbase) + (voff)[_i]), (PG8_LAS unsigned*)(lds + (bufoff) + ldsw + _i * 8192), 16, 0, 0); } while (0)
#define PG8_LDA(dst, b, h) do { if constexpr (F8) { _Pragma("unroll") for (int m = 0; m < 4; ++m) dst##8[m] = ld8(lds + PG8_SA(b, h) + aoff + m * 2048); } else { _Pragma("unroll") for (int m = 0; m < 4; ++m) _Pragma("unroll") for (int k = 0; k < 2; ++k) dst[m][k] = *(const PG8_LAS bf16x8*)(lds + PG8_SA(b, h) + aoff + m * 2048 + k * 1024); } } while (0)
#define PG8_LDB(dst, b, h) do { if constexpr (F8) { _Pragma("unroll") for (int n = 0; n < 2; ++n) dst##8[n] = ld8(lds + PG8_SB(b, h) + boff + n * 2048); } else { _Pragma("unroll") for (int n = 0; n < 2; ++n) _Pragma("unroll") for (int k = 0; k < 2; ++k) dst[n][k] = *(const PG8_LAS bf16x8*)(lds + PG8_SB(b, h) + boff + n * 2048 + k * 1024); } } while (0)
#define PG8_MMA(ai, bj, At, Bt) do { __builtin_amdgcn_s_setprio(1); if constexpr (F8 == 2) { _Pragma("unroll") for (int m = 0; m < 4; ++m) _Pragma("unroll") for (int n = 0; n < 2; ++n) \
        asm volatile("s_nop 1\n\tv_mfma_scale_f32_16x16x128_f8f6f4 %0, %1, %2, %0, %3, %4 op_sel_hi:[0,0,0] cbsz:2 blgp:2" : "+v"(acc[ai][bj][m][n]) : "v"(lo6(Bt##8[n])), "v"(lo6(At##8[m])), "v"(Bt##8[n][6]), "v"(At##8[m][6])); } else if constexpr (F8 == 1) { _Pragma("unroll") for (int m = 0; m < 4; ++m) _Pragma("unroll") for (int n = 0; n < 2; ++n) \
        asm volatile("s_nop 1\n\tv_mfma_scale_f32_16x16x128_f8f6f4 %0, %1, %2, %0, %3, %3 op_sel_hi:[0,0,0]" : "+v"(acc[ai][bj][m][n]) : "v"(Bt##8[n]), "v"(At##8[m]), "v"(scl8)); } else { \
        _Pragma("unroll") for (int m = 0; m < 4; ++m) _Pragma("unroll") for (int n = 0; n < 2; ++n) _Pragma("unroll") for (int k = 0; k < 2; ++k) \
        acc[ai][bj][m][n] = __builtin_amdgcn_mfma_f32_16x16x32_bf16(Bt[n][k], At[m][k], acc[ai][bj][m][n], 0, 0, 0); } __builtin_amdgcn_s_setprio(0); } while (0)
#define PG8_WAIT_V(n) asm volatile("s_waitcnt vmcnt(" #n ")" ::: "memory")
#define PG8_WAIT_L(n) asm volatile("s_waitcnt lgkmcnt(" #n ")" ::: "memory")
#define PG8_BAR __builtin_amdgcn_s_barrier()
#define PG8_SCHED __builtin_amdgcn_sched_barrier(0)
    Unit cur, nxt; int ui = 0;
    if (!S.next(0, cur)) return;
    f32x4 acc[2][2][4][2];
#pragma unroll
    for (int a = 0; a < 2; ++a)
#pragma unroll
        for (int b = 0; b < 2; ++b)
#pragma unroll
            for (int m = 0; m < 4; ++m)
#pragma unroll
                for (int n = 0; n < 2; ++n) acc[a][b][m][n] = (f32x4){0.f, 0.f, 0.f, 0.f};
    bf16x8 At[4][2], B0[2][2], B1[2][2]; v8i_t At8[4], B08[2], B18[2]; int scl8 = 0x7F7F7F7F; asm volatile("" : "+v"(scl8));
    const char* cA = (const char*)(g.A + (size_t)cur.z * g.sAz + (size_t)cur.pm * BM * g.lda); const char* cB = (const char*)(g.Bt + (size_t)cur.z * g.sBz + (size_t)cur.pn * BM * g.ldb);
    typename epi_state<Epi>::type est; if constexpr (epi_state<Epi>::has) E.prefetch(est, cur, wr, wc, fr, fq);
    S.a_ready(cur);
    if constexpr (SP2) {
        PG8_STAGE(PG8_SB(0, 0), cB, voffB); PG8_STAGE(PG8_SB(0, 1), cB + hstepB, voffB); PG8_STAGE(PG8_SA(0, 0), cA, voffA); PG8_STAGE(PG8_SA(0, 1), cA + hstepA, voffA);
        if (wr == 1) PG8_BAR;
        PG8_WAIT_V(2); PG8_BAR;
        PG8_STAGE(PG8_SB(1, 0), cB + kstep, voffB); PG8_STAGE(PG8_SA(1, 0), cA + kstep, voffA); PG8_STAGE(PG8_SB(1, 1), cB + hstepB + kstep, voffB);
        PG8_WAIT_V(6); PG8_BAR;
    } else {
        PG8_STAGE(PG8_SB(0, 0), cB, voffB); PG8_STAGE(PG8_SA(0, 0), cA, voffA); PG8_STAGE(PG8_SB(0, 1), cB + hstepB, voffB); PG8_STAGE(PG8_SA(0, 1), cA + hstepA, voffA);
        if (wr == 1) PG8_BAR;
        PG8_WAIT_V(4); PG8_BAR;
        PG8_STAGE(PG8_SB(1, 0), cB + kstep, voffB); PG8_STAGE(PG8_SA(1, 0), cA + kstep, voffA); PG8_STAGE(PG8_SB(1, 1), cB + hstepB + kstep, voffB);
        PG8_WAIT_V(6); PG8_BAR;
    }
    for (;;) {
        const bool has_next = S.next(ui + 1, nxt);
        const char* nA = has_next ? (const char*)(g.A + (size_t)nxt.z * g.sAz + (size_t)nxt.pm * BM * g.lda) : cA; const char* nB = has_next ? (const char*)(g.Bt + (size_t)nxt.z * g.sBz + (size_t)nxt.pn * BM * g.ldb) : cB;
        for (int t = 0; t < nt; t += 2) {
            const bool last = (t == nt - 2);
            const char* a1 = cA + (size_t)(t + 1) * kstep;
            const char* a2 = last ? nA : cA + (size_t)(t + 2) * kstep; const char* b2 = last ? nB : cB + (size_t)(t + 2) * kstep;
            const char* a3 = a2 + kstep; const char* b3 = b2 + kstep;
            if (last && has_next) S.a_ready(nxt);
            if constexpr (SP2) {
            PG8_LDB(B0, 0, 0); PG8_LDB(B1, 0, 1); PG8_SCHED; PG8_LDA(At, 0, 0); PG8_STAGE(PG8_SA(1, 1), a1 + hstepA, voffA);
            PG8_WAIT_V(8); PG8_WAIT_L(0); PG8_BAR; PG8_MMA(0, 0, At, B0); PG8_MMA(0, 1, At, B1); PG8_BAR; PG8_SCHED;
            PG8_LDA(At, 0, 1); PG8_STAGE(PG8_SB(0, 0), b2, voffB); PG8_STAGE(PG8_SB(0, 1), b2 + hstepB, voffB); PG8_STAGE(PG8_SA(0, 0), a2, voffA);
            PG8_WAIT_V(8); PG8_WAIT_L(0); PG8_BAR; PG8_MMA(1, 0, At, B0); PG8_MMA(1, 1, At, B1); PG8_BAR; PG8_SCHED;
            PG8_LDB(B0, 1, 0); PG8_LDB(B1, 1, 1); PG8_SCHED; PG8_LDA(At, 1, 0); PG8_STAGE(PG8_SA(0, 1), a2 + hstepA, voffA);
            PG8_WAIT_V(8); PG8_WAIT_L(0); PG8_BAR; PG8_MMA(0, 0, At, B0); PG8_MMA(0, 1, At, B1); PG8_BAR; PG8_SCHED;
            PG8_LDA(At, 1, 1); PG8_STAGE(PG8_SB(1, 0), b3, voffB); PG8_STAGE(PG8_SB(1, 1), b3 + hstepB, voffB); PG8_STAGE(PG8_SA(1, 0), a3, voffA);
            PG8_WAIT_V(8); PG8_WAIT_L(0); PG8_BAR; PG8_MMA(1, 0, At, B0); PG8_MMA(1, 1, At, B1); PG8_BAR; PG8_SCHED;
            } else {
            PG8_LDB(B0, 0, 0); PG8_SCHED; PG8_LDA(At, 0, 0); PG8_STAGE(PG8_SA(1, 1), a1 + hstepA, voffA);
            PG8_WAIT_L(8); PG8_BAR; PG8_WAIT_L(0); PG8_MMA(0, 0, At, B0); PG8_BAR; PG8_SCHED;
            PG8_LDB(B1, 0, 1); PG8_STAGE(PG8_SB(0, 0), b2, voffB);
            PG8_BAR; PG8_WAIT_L(0); PG8_MMA(0, 1, At, B1); PG8_BAR;
            PG8_LDA(At, 0, 1); PG8_STAGE(PG8_SA(0, 0), a2, voffA);
            PG8_BAR; PG8_WAIT_L(0); PG8_MMA(1, 0, At, B0); PG8_BAR; PG8_SCHED;
            PG8_STAGE(PG8_SB(0, 1), b2 + hstepB, voffB);
            PG8_WAIT_V(6); PG8_BAR; PG8_MMA(1, 1, At, B1); PG8_BAR;
            PG8_LDB(B0, 1, 0); PG8_SCHED; PG8_LDA(At, 1, 0); PG8_STAGE(PG8_SA(0, 1), a2 + hstepA, voffA);
            PG8_WAIT_L(8); PG8_BAR; PG8_WAIT_L(0); PG8_MMA(0, 0, At, B0); PG8_BAR; PG8_SCHED;
            PG8_LDB(B1, 1, 1); PG8_STAGE(PG8_SB(1, 0), b3, voffB);
            PG8_BAR; PG8_WAIT_L(0); PG8_MMA(0, 1, At, B1); PG8_BAR;
            PG8_LDA(At, 1, 1); PG8_STAGE(PG8_SA(1, 0), a3, voffA);
            PG8_BAR; PG8_WAIT_L(0); PG8_MMA(1, 0, At, B0); PG8_BAR; PG8_SCHED;
            PG8_STAGE(PG8_SB(1, 1), b3 + hstepB, voffB);
            PG8_WAIT_V(6); PG8_BAR; PG8_MMA(1, 1, At, B1); PG8_BAR;
            }
        }
        if constexpr (F8) asm volatile("s_nop 15\n\ts_nop 7" ::: "memory");
        if constexpr (ALIGN_EPI) { if (wr == 0) PG8_BAR; }
        if constexpr (!Epi::AFTER_DRAIN) { if constexpr (epi_state<Epi>::has) E(acc, cur, wr, wc, fr, fq, est); else E(acc, cur, wr, wc, fr, fq); S.done(cur); }
        if (!has_next) break;
#pragma unroll
        for (int a = 0; a < 2; ++a)
#pragma unroll
            for (int b = 0; b < 2; ++b)
#pragma unroll
                for (int m = 0; m < 4; ++m)
#pragma unroll
                    for (int n = 0; n < 2; ++n) acc[a][b][m][n] = (f32x4){0.f, 0.f, 0.f, 0.f};
        cur = nxt; cA = nA; cB = nB; ++ui; if constexpr (epi_state<Epi>::has) E.prefetch(est, cur, wr, wc, fr, fq);
        if constexpr (ALIGN_EPI) { if (wr == 1) PG8_BAR; }
    }
    PG8_WAIT_V(0);
    if constexpr (!ALIGN_EPI) { if (wr == 0) PG8_BAR; }
    PG8_BAR;
    if constexpr (Epi::AFTER_DRAIN) { E.fused(acc, cur, wr, wc, fr, fq, lds, wid, lane); S.done(cur); }
#undef PG8_SA
#undef PG8_SB
#undef PG8_STAGE
#undef PG8_LDA
#undef PG8_LDB
#undef PG8_MMA
#undef PG8_WAIT_V
#undef PG8_WAIT_L
#undef PG8_BAR
#undef PG8_SCHED
}
}


constexpr int T_ = 8192, DM = 4096, INW = 14336;
constexpr int MH = 16, MW = 2048, NBLK = 32;
constexpr int RH = 8;
constexpr int PH = 8, NEXP = 16384;
constexpr float NORM_EPS = 1e-6f, GN_EPS = 1e-6f;
constexpr float LOG2E = 1.4426950408889634f;
constexpr float QSCALE = 0.08838834764831845f * 1.4426950408889634f;

constexpr size_t MiB = 1u << 20;
constexpr size_t WS_CTL = 0, CTL_ZERO_BYTES = 1 * MiB;
constexpr size_t WS_TAB = 1 * MiB;
constexpr size_t TAB_BIAS = WS_TAB, TAB_KMEAN = WS_TAB + 65536, TAB_KEYS = WS_TAB + 524288;
constexpr size_t WS_ROPE = 2 * MiB;
constexpr size_t WS_WIN_T = 10 * MiB;
constexpr size_t WS_WIN8 = WS_WIN_T, WS_WINB = WS_WIN_T + 24 * MiB;
constexpr size_t WS_PROJ = 122 * MiB;
constexpr size_t PROJ_STRIDE = (size_t)T_ * 2048;
constexpr size_t WS_XN = 346 * MiB;
constexpr size_t WS_MIX = 410 * MiB;
constexpr size_t WS_WOUT_T = 474 * MiB;
constexpr size_t WS_WQ_T = 506 * MiB;
constexpr size_t WS_H1 = 522 * MiB;
constexpr size_t WS_U8 = 650 * MiB;
constexpr size_t WS_V8T = 714 * MiB;
constexpr size_t WS_W8 = 778 * MiB;
constexpr size_t WS_FREE = 906 * MiB;
constexpr size_t WS_END = 1024 * MiB;
constexpr size_t WS_PQ = WS_WIN_T;
constexpr size_t WS_KT = WS_WIN_T + 64 * MiB;
constexpr size_t WS_UT = WS_XN;
constexpr size_t WS_VS = WS_FREE;
constexpr size_t WS_LIST = WS_FREE + 64 * MiB;
constexpr size_t WS_ML = WS_FREE + 80 * MiB;
constexpr size_t WS_PART = WS_H1;
constexpr size_t WS_GW = WS_WIN_T;
constexpr size_t WS_PQP = WS_WIN_T + 256 * MiB;
constexpr size_t WS_XN8 = 410 * MiB;
constexpr size_t WS_BM = WS_FREE + 32 * MiB;
constexpr size_t WS_TN8 = WS_FREE;
constexpr float WIN8_SCALE = 1024.f, XN8_SCALE = 16.f;
constexpr float TN8_SCALE = 16.f, U8_SCALE = 1024.f, V8_SCALE = 32.f, W8_SCALE = 32.f;
static_assert(WS_PQP + 32 * MiB <= WS_XN && WS_ML + 4 * MiB <= WS_END && WS_KT + 32 * MiB <= WS_PROJ, "d_ws map");
constexpr int CW_BAR = 4096;
constexpr int CW_CNT = 16384;

constexpr int RING_BYTES = 155648;
constexpr int LDSCTL_OFF = RING_BYTES, MISC_OFF = LDSCTL_OFF + 64;
constexpr int LDS_BYTES = RING_BYTES + 256;

#define GAS __attribute__((address_space(1)))
#define LAS __attribute__((address_space(3)))
typedef unsigned short bf16;
typedef unsigned v4u __attribute__((ext_vector_type(4)));
typedef unsigned v2u __attribute__((ext_vector_type(2)));
typedef float f32x4 __attribute__((ext_vector_type(4)));
typedef float f32x2 __attribute__((ext_vector_type(2)));
typedef float f32x16 __attribute__((ext_vector_type(16)));
typedef short bf16x8 __attribute__((ext_vector_type(8)));
typedef short s16x4 __attribute__((ext_vector_type(4)));
typedef short s16x2 __attribute__((ext_vector_type(2)));
typedef short v4i16_t __attribute__((ext_vector_type(4)));
#define LDS_WAIT() asm volatile("s_waitcnt lgkmcnt(0)" ::: "memory")
#define VM_WAIT() asm volatile("s_waitcnt vmcnt(0)" ::: "memory")
__device__ __forceinline__ unsigned f2bf(float f) { unsigned u = __builtin_bit_cast(unsigned, f); return (u + 0x7fffu + ((u >> 16) & 1u)) >> 16; }
__device__ __forceinline__ unsigned pk2(float lo, float hi) { return f2bf(lo) | (f2bf(hi) << 16); }
__device__ __forceinline__ float clamp448(float x) { return __builtin_fminf(__builtin_fmaxf(x, -448.f), 448.f); }
__device__ __forceinline__ unsigned pk4_fp8(float a, float b, float c, float d) { int r = 0; r = __builtin_amdgcn_cvt_pk_fp8_f32(clamp448(a), clamp448(b), r, false); r = __builtin_amdgcn_cvt_pk_fp8_f32(clamp448(c), clamp448(d), r, true); return (unsigned)r; }
__device__ __forceinline__ float bflo(unsigned w) { return __builtin_bit_cast(float, w << 16); }
__device__ __forceinline__ float bfhi(unsigned w) { return __builtin_bit_cast(float, w & 0xffff0000u); }

#define XB_TMO      128
#define XB_XCNT(j)  (256  + 64 * (j))
#define XB_XSUB(j)  (1280 + 64 * (j))
#define XB_XGEN(j)  (2304 + 64 * (j))
#define XB_TOP      3328
#define XB_TOPGEN   3392
#define XCD_BAR_WORDS 3456
#define XB_SPIN_CAP (1u << 18)

__device__ __forceinline__ unsigned xb_ld(unsigned* p)              { return __hip_atomic_load(p, __ATOMIC_RELAXED, __HIP_MEMORY_SCOPE_AGENT); }
__device__ __forceinline__ unsigned xb_add(unsigned* p, unsigned v) { return __hip_atomic_fetch_add(p, v, __ATOMIC_RELAXED, __HIP_MEMORY_SCOPE_AGENT); }
__device__ __forceinline__ unsigned xb_xcc_id() { return (unsigned)__builtin_amdgcn_s_getreg((3 << 11) | 20) & 0xFu; }
#define XB_SPIN(cond, bar) do { unsigned _sp = 0; while (cond) { __builtin_amdgcn_s_sleep(1); \
    if ((++_sp & 255u) == 0u) { if (xb_ld(&(bar)[XB_TMO])) break; if (_sp > XB_SPIN_CAP) { atomicAdd(&(bar)[XB_TMO], 1u); break; } } } } while (0)

struct XcdBarrier {
    unsigned* bar; unsigned x;
    volatile LAS unsigned* st;
};

__device__ __forceinline__ XcdBarrier xcd_barrier_post(unsigned* bar, volatile LAS unsigned* st) {
    XcdBarrier b; b.bar = bar; b.x = xb_xcc_id(); b.st = st;
    if (threadIdx.x == 0) (void)xb_add(&bar[XB_XCNT(b.x)], 1u);
    return b;
}
__device__ __forceinline__ void xcd_barrier_complete(unsigned* bar, unsigned x, unsigned& nloc, unsigned& nx) {
    const unsigned G = gridDim.x * gridDim.y * gridDim.z;
    unsigned sum, cnt, mine, sp = 0u;
    for (;;) {
        sum = 0u; cnt = 0u; mine = 0u;
#pragma unroll
        for (unsigned j = 0; j < 16; ++j) { const unsigned c = xb_ld(&bar[XB_XCNT(j)]); sum += c; cnt += (c > 0u) ? 1u : 0u; mine = (j == x) ? c : mine; }
        if (sum == G) break;
        __builtin_amdgcn_s_sleep(1);
        if ((++sp & 255u) == 0u) { if (xb_ld(&bar[XB_TMO])) break; if (sp > XB_SPIN_CAP) { atomicAdd(&bar[XB_TMO], 1u); break; } }
    }
    nloc = mine > 0u ? mine : 1u; nx = cnt > 0u ? cnt : 1u;
}

__device__ __forceinline__ void xcd_barrier(const XcdBarrier& b) {
    asm volatile("s_waitcnt vmcnt(0)" ::: "memory");
    __syncthreads();
    if (threadIdx.x == 0) {
        unsigned* bar = b.bar;
        __builtin_amdgcn_s_waitcnt(0);
        unsigned nloc = b.st[0], nx = b.st[1];
        if (nloc == 0u) { xcd_barrier_complete(bar, b.x, nloc, nx); b.st[0] = nloc; b.st[1] = nx; }
        const unsigned old = xb_add(&bar[XB_XSUB(b.x)], 1u);
        const unsigned gen = old / nloc;
        if (old + 1u == (gen + 1u) * nloc) {
            __builtin_amdgcn_fence(__ATOMIC_RELEASE, "agent");
            asm volatile("s_waitcnt vmcnt(0)" ::: "memory");
            const unsigned og = xb_add(&bar[XB_TOP], 1u);
            const unsigned tg = og / nx;
            if (og + 1u == (tg + 1u) * nx) xb_add(&bar[XB_TOPGEN], 1u);
            else XB_SPIN(xb_ld(&bar[XB_TOPGEN]) == tg, bar);
            __builtin_amdgcn_fence(__ATOMIC_ACQUIRE, "agent");
            xb_add(&bar[XB_XGEN(b.x)], 1u);
            asm volatile("s_waitcnt vmcnt(0)" ::: "memory");
        } else {
            XB_SPIN(xb_ld(&bar[XB_XGEN(b.x)]) == gen, bar);
            __builtin_amdgcn_fence(__ATOMIC_ACQUIRE, "agent");
            asm volatile("s_waitcnt vmcnt(0)" ::: "memory");
        }
    }
    __syncthreads();
}


struct Frame {
    LAS unsigned char* lds;
    int tid, lane, wave, G, gw, NGW;
};
__device__ __forceinline__ float wave_sum(float v) {
#pragma unroll
    for (int o = 1; o < 64; o <<= 1) v += __shfl_xor(v, o);
    return v;
}

__device__ __forceinline__ void p0_transpose_item(const float* W, int K, int N, int ldw, bf16* WT, LAS float* scr, int item, int lane) {
    const int nblk = N / 64, kb = item / nblk, nb = item % nblk, k0 = 64 * kb, n0 = 64 * nb;
    { const int c4 = lane & 15, kr = lane >> 4; f32x4 v[16];
#pragma unroll
      for (int i = 0; i < 16; ++i) v[i] = __builtin_nontemporal_load((const GAS f32x4*)(W + (size_t)(k0 + 4 * i + kr) * ldw + n0 + 4 * c4));
#pragma unroll
      for (int i = 0; i < 16; ++i) { const int k = 4 * i + kr; *(LAS f32x4*)(scr + k * 64 + ((c4 ^ ((k >> 3) & 15)) << 2)) = v[i]; } }
    LDS_WAIT(); asm volatile("" ::: "memory");
    const int c = lane & 7;
#pragma unroll
    for (int j = 0; j < 8; ++j) { const int n = (lane >> 3) + 8 * j; const LAS float* p = scr + (8 * c) * 64 + ((((n >> 2) ^ c) & 15) << 2) + (n & 3);
        v4u o; o.x = pk2(p[0 * 64], p[1 * 64]); o.y = pk2(p[2 * 64], p[3 * 64]); o.z = pk2(p[4 * 64], p[5 * 64]); o.w = pk2(p[6 * 64], p[7 * 64]);
        *(GAS v4u*)(WT + (size_t)(n0 + n) * K + k0 + 8 * c) = o; }
    LDS_WAIT(); asm volatile("" ::: "memory");
}
__device__ __forceinline__ void p0_transpose_item_fp8(const float* W, int K, int N, int ldw, unsigned char* WT, float scale, LAS float* scr, int item, int lane) {
    const int nblk = N / 32, kb = item / nblk, nb = item % nblk, k0 = 128 * kb, n0 = 32 * nb;
    { const int c4 = lane & 7, kr = lane >> 3; f32x4 v[16];
#pragma unroll
      for (int i = 0; i < 16; ++i) v[i] = __builtin_nontemporal_load((const GAS f32x4*)(W + (size_t)(k0 + 8 * i + kr) * ldw + n0 + 4 * c4));
#pragma unroll
      for (int i = 0; i < 16; ++i) { const int k = 8 * i + kr; *(LAS f32x4*)(scr + k * 32 + ((c4 ^ ((k >> 4) & 7)) << 2)) = v[i] * scale; } }
    LDS_WAIT(); asm volatile("" ::: "memory");
    const int c = lane & 7;
#pragma unroll
    for (int j = 0; j < 4; ++j) { const int n = (lane >> 3) + 8 * j; const LAS float* p = scr + (16 * c) * 32 + ((((n >> 2) ^ c) & 7) << 2) + (n & 3);
        v4u o; o.x = pk4_fp8(p[0 * 32], p[1 * 32], p[2 * 32], p[3 * 32]); o.y = pk4_fp8(p[4 * 32], p[5 * 32], p[6 * 32], p[7 * 32]);
        o.z = pk4_fp8(p[8 * 32], p[9 * 32], p[10 * 32], p[11 * 32]); o.w = pk4_fp8(p[12 * 32], p[13 * 32], p[14 * 32], p[15 * 32]);
        *(GAS v4u*)(WT + (size_t)(n0 + n) * K + k0 + 16 * c) = o; }
    LDS_WAIT(); asm volatile("" ::: "memory");
}
template <int MODE> __device__ __forceinline__ void rms_row_to_bf16(int lane, const float* xrow, const float* g, bf16* orow, unsigned char* o8row = nullptr) {
    const GAS f32x4* xr = (const GAS f32x4*)xrow + lane; const GAS f32x4* gr = (const GAS f32x4*)g + lane;
    f32x4 v[16]; float s = 0.f;
#pragma unroll
    for (int j = 0; j < 16; ++j) { v[j] = xr[64 * j]; s += (v[j].x * v[j].x + v[j].y * v[j].y) + (v[j].z * v[j].z + v[j].w * v[j].w); }
    const float rstd = 1.f / sqrtf(wave_sum(s) * (1.f / DM) + NORM_EPS);
    GAS v2u* o8 = (GAS v2u*)orow + lane;
#pragma unroll
    for (int j = 0; j < 16; ++j) { const f32x4 gg = gr[64 * j]; const f32x4 y = v[j] * rstd * gg; if constexpr (MODE != 2) { v2u w; w.x = pk2(y.x, y.y); w.y = pk2(y.z, y.w); o8[64 * j] = w; }
        if constexpr (MODE != 0) { const f32x4 ys = y * 16.f; ((GAS unsigned*)o8row)[lane + 64 * j] = pk4_fp8(ys.x, ys.y, ys.z, ys.w); } }
}
__constant__ unsigned char T5_BUCKET[129] = {0, 1, 2, 3, 4, 5, 6, 7, 8, 9, 10, 11, 12, 13, 14, 15, 16, 16, 16, 17, 17, 18, 18, 18, 19, 19, 19, 20, 20, 20, 20, 21, 21, 21, 21, 22, 22, 22, 22, 22, 23, 23, 23, 23, 23, 23, 24, 24, 24, 24, 24, 24, 25, 25, 25, 25, 25, 25, 25, 26, 26, 26, 26, 26, 26, 26, 26, 27, 27, 27, 27, 27, 27, 27, 27, 27, 27, 28, 28, 28, 28, 28, 28, 28, 28, 28, 28, 29, 29, 29, 29, 29, 29, 29, 29, 29, 29, 29, 29, 30, 30, 30, 30, 30, 30, 30, 30, 30, 30, 30, 30, 30, 30, 31, 31, 31, 31, 31, 31, 31, 31, 31, 31, 31, 31, 31, 31, 31, 31};

struct Args { const float* in[11]; float* out; unsigned char* ws; int ph_lo, ph_hi; };

__device__ __forceinline__ void p0_prologue(Frame& F, const Args& a) {
    unsigned char* ws = a.ws;
    LAS float* scr = (LAS float*)(F.lds + F.wave * 16384);
    const int gw = F.gw, NGW = F.NGW;
    const float* w_in = a.in[2]; const float* w_out = a.in[3]; const float* w_q = a.in[6]; const float* pv = a.in[9];
    constexpr int NMOBA = 3 * MW, NRET = INW - NMOBA;
    constexpr int I_INA = (DM / 128) * (NMOBA / 32), I_INB = (DM / 64) * (NRET / 64), I_OUT = (DM / 64) * (DM / 64), I_Q = (DM / 64) * (2048 / 64), I_V = (NEXP / 128) * (DM / 32);
    constexpr int NITEMS = I_INA + I_INB + I_OUT + I_Q + I_V;
    for (int it = gw; it < NITEMS; it += NGW) {
        int r = it;
        if (r < I_INA) { p0_transpose_item_fp8(w_in, DM, NMOBA, INW, ws + WS_WIN8, WIN8_SCALE, scr, r, F.lane); continue; } r -= I_INA;
        if (r < I_INB) { p0_transpose_item(w_in + NMOBA, DM, NRET, INW, (bf16*)(ws + WS_WINB), scr, r, F.lane); continue; } r -= I_INB;
        if (r < I_OUT) { p0_transpose_item(w_out, DM, DM, DM, (bf16*)(ws + WS_WOUT_T), scr, r, F.lane); continue; } r -= I_OUT;
        if (r < I_Q) { p0_transpose_item(w_q, DM, 2048, 2048, (bf16*)(ws + WS_WQ_T), scr, r, F.lane); continue; } r -= I_Q;
        p0_transpose_item_fp8(pv, NEXP, DM, DM, ws + WS_V8T, V8_SCALE, scr, r, F.lane);
    }
    { const GAS f32x4* src = (const GAS f32x4*)a.in[8]; GAS v4u* dst = (GAS v4u*)(ws + WS_U8);
      const size_t n16 = (size_t)NEXP * DM / 16, stride = (size_t)NGW * 64;
      for (size_t i0 = (size_t)gw * 64 + F.lane; i0 < n16; i0 += 4 * stride) { f32x4 x[4][4];
#pragma unroll
          for (int r = 0; r < 4; ++r) { const size_t i = i0 + r * stride; if (i < n16) {
#pragma unroll
              for (int q = 0; q < 4; ++q) x[r][q] = __builtin_nontemporal_load(src + 4 * i + q); } }
#pragma unroll
          for (int r = 0; r < 4; ++r) { const size_t i = i0 + r * stride; if (i < n16) { v4u o;
              o.x = pk4_fp8(x[r][0].x * U8_SCALE, x[r][0].y * U8_SCALE, x[r][0].z * U8_SCALE, x[r][0].w * U8_SCALE); o.y = pk4_fp8(x[r][1].x * U8_SCALE, x[r][1].y * U8_SCALE, x[r][1].z * U8_SCALE, x[r][1].w * U8_SCALE);
              o.z = pk4_fp8(x[r][2].x * U8_SCALE, x[r][2].y * U8_SCALE, x[r][2].z * U8_SCALE, x[r][2].w * U8_SCALE); o.w = pk4_fp8(x[r][3].x * U8_SCALE, x[r][3].y * U8_SCALE, x[r][3].z * U8_SCALE, x[r][3].w * U8_SCALE); dst[i] = o; } } } }
    { const GAS f32x4* src = (const GAS f32x4*)a.in[7]; GAS v4u* dst = (GAS v4u*)(ws + TAB_KEYS);
      const size_t n8 = (size_t)262144 / 8, stride = (size_t)NGW * 64;
      for (size_t i = (size_t)gw * 64 + F.lane; i < n8; i += stride) { const f32x4 x0 = src[2 * i], x1 = src[2 * i + 1]; v4u o; o.x = pk2(x0.x, x0.y); o.y = pk2(x0.z, x0.w); o.z = pk2(x1.x, x1.y); o.w = pk2(x1.z, x1.w); dst[i] = o; } }
    for (int m = gw; m < T_; m += NGW) rms_row_to_bf16<1>(F.lane, a.in[0] + (size_t)m * DM, a.in[1], (bf16*)(ws + WS_XN) + (size_t)m * DM, ws + WS_XN8 + (size_t)m * DM);
    { float* COS = (float*)(ws + WS_ROPE); float* SIN = COS + (size_t)T_ * 128;
      for (int i = gw * 64 + F.lane; i < T_ * 128; i += NGW * 64) { const int t = i >> 7, f = i & 127;
          const double inv = exp2(-(double)f * (13.287712379549449 / 128.0));
          const double rev = (double)t * inv * 0.15915494309189535;
          const float fr = (float)(rev - floor(rev));
          COS[i] = __builtin_amdgcn_cosf(fr); SIN[i] = __builtin_amdgcn_sinf(fr); } }
    { float* tb = (float*)(ws + TAB_BIAS); const float* rb = a.in[4];
      for (int i = gw * 64 + F.lane; i < 16 * 132; i += NGW * 64) { const int h = i / 132, n = i % 132; tb[i] = rb[(int)T5_BUCKET[n > 128 ? 128 : n] * 16 + h] * LOG2E; } }
}

namespace pg8 {
struct EpiResF32 {
    static constexpr bool PERM = false, AFTER_DRAIN = false;
    const float* base; float* C; int ldc; float scale;
    __device__ __forceinline__ void operator()(const f32x4 (&acc)[2][2][4][2], const Unit& u, int wr, int wc, int fr, int fq) const {
        const int row0 = u.pm * BM + wr * 64 + fr, col0 = u.pn * BM + wc * 32 + 4 * fq;
#pragma unroll
        for (int ai = 0; ai < 2; ++ai)
#pragma unroll
            for (int m = 0; m < 4; ++m) { const size_t off = (size_t)(row0 + ai * HALF + m * 16) * ldc + col0;
#pragma unroll
                for (int bj = 0; bj < 2; ++bj)
#pragma unroll
                    for (int n = 0; n < 2; ++n) { const f32x4 b = *(const f32x4*)(base + off + bj * HALF + n * 16); *(f32x4*)(C + off + bj * HALF + n * 16) = acc[ai][bj][m][n] * scale + b; } }
    }
};
struct EpiF32Z {
    static constexpr bool PERM = false, AFTER_DRAIN = false;
    float* C;
    __device__ __forceinline__ void operator()(const f32x4 (&acc)[2][2][4][2], const Unit& u, int wr, int wc, int fr, int fq) const {
        float* Cz = C + (size_t)u.z * 65536; const int row0 = wr * 64 + fr, col0 = wc * 32 + 4 * fq;
#pragma unroll
        for (int ai = 0; ai < 2; ++ai)
#pragma unroll
            for (int m = 0; m < 4; ++m) { float* rowp = Cz + (size_t)(row0 + ai * HALF + m * 16) * 256 + col0;
#pragma unroll
                for (int bj = 0; bj < 2; ++bj)
#pragma unroll
                    for (int n = 0; n < 2; ++n) *(f32x4*)(rowp + bj * HALF + n * 16) = acc[ai][bj][m][n]; }
    }
};
struct EpiRetP {
    static constexpr bool PERM = true, AFTER_DRAIN = false;
    bf16_t* PQ;
    __device__ __forceinline__ void operator()(const f32x4 (&acc)[2][2][4][2], const Unit& u, int wr, int wc, int fr, int fq) const {
        asm volatile("" : "+v"(fr), "+v"(fq));
        const int h = u.z; const float lg = __builtin_log2f(1.f - __builtin_exp2f(-5.f - (float)h));
        bf16_t* base = PQ + (size_t)(u.z * 32 + u.pm) * 131072;
#pragma unroll
        for (int ai = 0; ai < 2; ++ai)
#pragma unroll
            for (int m = 0; m < 4; ++m) { int i = ai * HALF + wr * 64 + m * 16 + fr;
                float lgv = lg; asm volatile("" : "+v"(lgv), "+v"(i));
#pragma unroll
                for (int bj = 0; bj < 2; ++bj) { const int j0 = bj * HALF + wc * 32 + 8 * fq; float v[8];
#pragma unroll
                    for (int e = 0; e < 8; ++e) { const int dd = i - (j0 + e); const float a = e < 4 ? acc[ai][bj][m][0][e & 3] : acc[ai][bj][m][1][e & 3];
                        v[e] = dd >= 0 ? a * __builtin_amdgcn_exp2f((float)dd * lgv) : 0.f; }
                    u32x4 w; w.x = cvt_pk_bf16(v[0], v[1]); w.y = cvt_pk_bf16(v[2], v[3]); w.z = cvt_pk_bf16(v[4], v[5]); w.w = cvt_pk_bf16(v[6], v[7]);
                    *(u32x4*)(base + (size_t)i * 512 + j0) = w; } }
    }
};
struct EpiRetOut {
    static constexpr bool PERM = true, AFTER_DRAIN = true;
    const bf16_t* RG; bf16_t* MIX;
    __device__ __forceinline__ void fused(f32x4 (&acc)[2][2][4][2], const Unit& u, int wr, int wc, int fr, int fq, PG8_LAS unsigned char* lds, int wid, int lane) const {
        PG8_LAS f32x2* P = (PG8_LAS f32x2*)lds;
#pragma unroll
        for (int ai = 0; ai < 2; ++ai)
#pragma unroll
            for (int m = 0; m < 4; ++m) { float s = 0.f, q = 0.f;
#pragma unroll
                for (int bj = 0; bj < 2; ++bj)
#pragma unroll
                    for (int n = 0; n < 2; ++n) { const f32x4 x = acc[ai][bj][m][n]; s += (x[0] + x[1]) + (x[2] + x[3]); q += (x[0] * x[0] + x[1] * x[1]) + (x[2] * x[2] + x[3] * x[3]); }
                s += __shfl_xor(s, 16); s += __shfl_xor(s, 32); q += __shfl_xor(q, 16); q += __shfl_xor(q, 32);
                if (fq == 0) P[(ai * HALF + wr * 64 + m * 16 + fr) * 4 + wc] = (f32x2){s, q}; }
        asm volatile("s_waitcnt lgkmcnt(0)" ::: "memory"); __builtin_amdgcn_s_barrier(); asm volatile("" ::: "memory");
        const int h = u.z >> 5, c = u.z & 31;
#pragma unroll
        for (int ai = 0; ai < 2; ++ai)
#pragma unroll
            for (int m = 0; m < 4; ++m) { const int i = ai * HALF + wr * 64 + m * 16 + fr;
                const f32x2 p0 = P[i * 4 + 0], p1 = P[i * 4 + 1], p2 = P[i * 4 + 2], p3 = P[i * 4 + 3];
                const float mean = ((p0.x + p1.x) + (p2.x + p3.x)) * (1.f / 256.f); float var = ((p0.y + p1.y) + (p2.y + p3.y)) * (1.f / 256.f) - mean * mean; var = var < 0.f ? 0.f : var;
                const float rstd = 1.f / sqrtf(var + 1e-6f);
                const size_t t = (size_t)c * 256 + i;
#pragma unroll
                for (int bj = 0; bj < 2; ++bj) { const int e0 = bj * HALF + wc * 32 + 8 * fq;
                    const u32x4 gw = *(const u32x4*)(RG + t * 2048 + h * 256 + e0); float g[8];
                    g[0] = __builtin_bit_cast(float, gw.x << 16); g[1] = __builtin_bit_cast(float, gw.x & 0xffff0000u); g[2] = __builtin_bit_cast(float, gw.y << 16); g[3] = __builtin_bit_cast(float, gw.y & 0xffff0000u);
                    g[4] = __builtin_bit_cast(float, gw.z << 16); g[5] = __builtin_bit_cast(float, gw.z & 0xffff0000u); g[6] = __builtin_bit_cast(float, gw.w << 16); g[7] = __builtin_bit_cast(float, gw.w & 0xffff0000u);
                    float v[8];
#pragma unroll
                    for (int e = 0; e < 8; ++e) { const float a = e < 4 ? acc[ai][bj][m][0][e & 3] : acc[ai][bj][m][1][e & 3]; const float y = (a - mean) * rstd;
                        const float sg = g[e] * __builtin_amdgcn_rcpf(1.f + __builtin_amdgcn_exp2f(-g[e] * 1.4426950408889634f)); v[e] = y * sg; }
                    u32x4 w; w.x = cvt_pk_bf16(v[0], v[1]); w.y = cvt_pk_bf16(v[2], v[3]); w.z = cvt_pk_bf16(v[4], v[5]); w.w = cvt_pk_bf16(v[6], v[7]);
                    *(u32x4*)(MIX + t * 4096 + 2048 + h * 256 + e0) = w; } }
    }
};
template <int MODE> struct EpiPeerW8 {
    static constexpr bool PERM = true, AFTER_DRAIN = false;
    const bf16_t* G; const unsigned* BMP; unsigned char* W8; float sacc, sw;
    struct State { unsigned bm[8]; };
    __device__ __forceinline__ void prefetch(State& st, const Unit& u, int wr, int wc, int fr, int fq) const {
        const int row0 = u.pm * BM + wr * 64 + fr;
#pragma unroll
        for (int ai = 0; ai < 2; ++ai)
#pragma unroll
            for (int m = 0; m < 4; ++m) st.bm[ai * 4 + m] = MODE == 2 ? 0u : BMP[(size_t)(row0 + ai * HALF + m * 16) * 64 + u.pn];
    }
    __device__ __forceinline__ void operator()(const f32x4 (&acc)[2][2][4][2], const Unit& u, int wr, int wc, int fr, int fq, const State& st) const {
        const int row0 = u.pm * BM + wr * 64 + fr, col0 = u.pn * BM + wc * 32 + 8 * fq;
        typedef unsigned u32x2 __attribute__((ext_vector_type(2)));
        u32x4 gwv[2][4][2];
#pragma unroll
        for (int ai = 0; ai < 2; ++ai)
#pragma unroll
            for (int m = 0; m < 4; ++m) { const size_t ro = (size_t)(row0 + ai * HALF + m * 16) * 16384 + col0;
                const unsigned bm = MODE == 2 ? (unsigned)((row0 + m) * 2654435761u) & (unsigned)(((row0 + m) * 40503u) >> 3) & (unsigned)((row0 + m) * 97u) : st.bm[ai * 4 + m];
#pragma unroll
                for (int bj = 0; bj < 2; ++bj) { gwv[ai][m][bj] = (u32x4){0u, 0u, 0u, 0u};
                    if ((bm >> (16 * bj + 4 * wc + fq)) & 1u) gwv[ai][m][bj] = MODE == 2 ? (u32x4){0x3f803f80u, 0x3f803f80u, 0x3f803f80u, 0x3f803f80u} : *(const u32x4*)(G + ro + bj * HALF); } }
#pragma unroll
        for (int ai = 0; ai < 2; ++ai)
#pragma unroll
            for (int m = 0; m < 4; ++m) { const size_t ro = (size_t)(row0 + ai * HALF + m * 16) * 16384 + col0;
#pragma unroll
                for (int bj = 0; bj < 2; ++bj) { unsigned w0 = 0u, w1 = 0u; const u32x4 gw = gwv[ai][m][bj];
                    if ((gw.x | gw.y | gw.z | gw.w) != 0u) {
                        const f32x4 v0 = acc[ai][bj][m][0] * sacc, v1 = acc[ai][bj][m][1] * sacc;
                        f32x2 a = (f32x2){v0[0], v0[1]}, b = (f32x2){v0[2], v0[3]}, c = (f32x2){v1[0], v1[1]}, d = (f32x2){v1[2], v1[3]};
                        if constexpr (MODE == 0) { a = gelu_pk(a); b = gelu_pk(b); c = gelu_pk(c); d = gelu_pk(d); }
                        float r[8];
                        r[0] = a.x * __builtin_bit_cast(float, gw.x << 16); r[1] = a.y * __builtin_bit_cast(float, gw.x & 0xffff0000u);
                        r[2] = b.x * __builtin_bit_cast(float, gw.y << 16); r[3] = b.y * __builtin_bit_cast(float, gw.y & 0xffff0000u);
                        r[4] = c.x * __builtin_bit_cast(float, gw.z << 16); r[5] = c.y * __builtin_bit_cast(float, gw.z & 0xffff0000u);
                        r[6] = d.x * __builtin_bit_cast(float, gw.w << 16); r[7] = d.y * __builtin_bit_cast(float, gw.w & 0xffff0000u);
                        int t0 = 0, t1 = 0;
                        t0 = __builtin_amdgcn_cvt_pk_fp8_f32(r[0] * sw, r[1] * sw, t0, false); t0 = __builtin_amdgcn_cvt_pk_fp8_f32(r[2] * sw, r[3] * sw, t0, true);
                        t1 = __builtin_amdgcn_cvt_pk_fp8_f32(r[4] * sw, r[5] * sw, t1, false); t1 = __builtin_amdgcn_cvt_pk_fp8_f32(r[6] * sw, r[7] * sw, t1, true);
                        w0 = (unsigned)t0; w1 = (unsigned)t1; }
                    *(u32x2*)(W8 + ro + bj * HALF) = (u32x2){w0, w1}; } }
    }
};
struct BatchOrder {
    int nz, G, c;
    __device__ bool next(int i, Unit& u) const { const int L = i * G + c; if (L >= nz) return false; u.pm = 0; u.pn = 0; u.z = L; return true; }
    __device__ __forceinline__ void a_ready(const Unit&) const {}
    __device__ __forceinline__ void done(const Unit&) const {}
};
struct HOrder { int G, c; __device__ bool next(int i, Unit& u) const { const int L = i * G + c; if (L >= 256) return false; u.z = L >> 5; u.pm = L & 31; u.pn = L & 31; return true; }
                __device__ __forceinline__ void a_ready(const Unit&) const {} __device__ __forceinline__ void done(const Unit&) const {} };
struct OneOrder { int z; __device__ bool next(int i, Unit& u) const { if (i > 0 || z >= 256) return false; u.pm = 0; u.pn = 0; u.z = z; return true; }
                  __device__ __forceinline__ void a_ready(const Unit&) const {} __device__ __forceinline__ void done(const Unit&) const {} };
}

__device__ __forceinline__ int tr_off(int d, int j) { return d * 512 + ((((j >> 3) ^ (d >> 3)) & 31) << 4) + ((j & 7) << 1); }
__device__ __forceinline__ void unpack8(const v4u w, float (&f)[8]) { f[0] = bflo(w.x); f[1] = bfhi(w.x); f[2] = bflo(w.y); f[3] = bfhi(w.y); f[4] = bflo(w.z); f[5] = bfhi(w.z); f[6] = bflo(w.w); f[7] = bfhi(w.w); }
__device__ __forceinline__ v4u pack8(const float (&f)[8]) { v4u o; o.x = pk2(f[0], f[1]); o.y = pk2(f[2], f[3]); o.z = pk2(f[4], f[5]); o.w = pk2(f[6], f[7]); return o; }

template <bool NOSTORE> __device__ __forceinline__ void p2_prep(Frame& F, unsigned char* ws) {
    bf16* RQ = (bf16*)(ws + WS_PROJ) + 3 * PROJ_STRIDE; bf16* RK = RQ + PROJ_STRIDE; bf16* RV = RK + PROJ_STRIDE;
    const float* COS = (const float*)(ws + WS_ROPE); const float* SIN = COS + (size_t)T_ * 128;
    bf16* PQ = (bf16*)(ws + WS_PQ); bf16* KT = (bf16*)(ws + WS_KT); bf16* VS = (bf16*)(ws + WS_VS);
    LAS unsigned char* Tl = F.lds;
    const int l16 = F.tid & 15, trow = F.tid >> 4, d0 = l16 * 8;
    for (int item = blockIdx.x; item < 256; item += F.G) {
        const int h = item >> 5, c = item & 31;
        const float lg = __builtin_log2f(1.f - __builtin_exp2f(-5.f - (float)h));
#pragma unroll 2
        for (int step = 0; step < 8; ++step) {
            const int j = step * 32 + trow; const size_t t = (size_t)c * 256 + j;
            bf16* kp = RK + t * 2048 + h * 256 + d0;
            float lo[8], hi[8], cs[8], sn[8];
            unpack8(*(const GAS v4u*)kp, lo); unpack8(*(const GAS v4u*)(kp + 128), hi);
            { const f32x4 c0 = *(const GAS f32x4*)(COS + t * 128 + d0), c1 = *(const GAS f32x4*)(COS + t * 128 + d0 + 4), s0 = *(const GAS f32x4*)(SIN + t * 128 + d0), s1 = *(const GAS f32x4*)(SIN + t * 128 + d0 + 4);
              cs[0] = c0.x; cs[1] = c0.y; cs[2] = c0.z; cs[3] = c0.w; cs[4] = c1.x; cs[5] = c1.y; cs[6] = c1.z; cs[7] = c1.w;
              sn[0] = s0.x; sn[1] = s0.y; sn[2] = s0.z; sn[3] = s0.w; sn[4] = s1.x; sn[5] = s1.y; sn[6] = s1.z; sn[7] = s1.w; }
            float nl[8], nh[8];
#pragma unroll
            for (int i = 0; i < 8; ++i) { nl[i] = (lo[i] * cs[i] - hi[i] * sn[i]) * 0.0625f; nh[i] = (lo[i] * sn[i] + hi[i] * cs[i]) * 0.0625f; }
            if constexpr (!NOSTORE) { *(GAS v4u*)kp = pack8(nl); *(GAS v4u*)(kp + 128) = pack8(nh); }
            const float dec = __builtin_amdgcn_exp2f((float)(255 - j) * lg);
#pragma unroll
            for (int i = 0; i < 8; ++i) { *(LAS bf16*)(Tl + tr_off(d0 + i, j)) = (bf16)f2bf(nl[i] * dec); *(LAS bf16*)(Tl + tr_off(128 + d0 + i, j)) = (bf16)f2bf(nh[i] * dec); }
        }
        LDS_WAIT(); __syncthreads();
#pragma unroll 4
        for (int n = 0; n < 16; ++n) { const int id = F.tid + 512 * n, d = id >> 5, chp = id & 31, jl = (chp ^ (d >> 3)) & 31;
            const v4u tv = *(const LAS v4u*)(Tl + d * 512 + chp * 16); if constexpr (!NOSTORE) *(GAS v4u*)(KT + (size_t)item * 65536 + d * 256 + jl * 8) = tv; else if (tv.x == 0x12345678u && tv.y == 0x9abcdef0u) *(GAS v4u*)(KT + (size_t)item * 65536 + d * 256 + jl * 8) = tv; }
        LDS_WAIT(); __syncthreads();
#pragma unroll 4
        for (int step = 0; step < 8; ++step) {
            const int j = step * 32 + trow; const size_t t = (size_t)c * 256 + j;
            const bf16* vp = RV + t * 2048 + h * 256 + d0;
            const v4u a = *(const GAS v4u*)vp, b = *(const GAS v4u*)(vp + 128);
            const unsigned aw[4] = {a.x, a.y, a.z, a.w}, bw[4] = {b.x, b.y, b.z, b.w};
#pragma unroll
            for (int i = 0; i < 8; ++i) { *(LAS bf16*)(Tl + tr_off(d0 + i, j)) = (bf16)((i & 1) ? (aw[i >> 1] >> 16) : (aw[i >> 1] & 0xffffu)); *(LAS bf16*)(Tl + tr_off(128 + d0 + i, j)) = (bf16)((i & 1) ? (bw[i >> 1] >> 16) : (bw[i >> 1] & 0xffffu)); }
        }
        LDS_WAIT(); __syncthreads();
#pragma unroll 4
        for (int n = 0; n < 16; ++n) { const int id = F.tid + 512 * n, d = id >> 5, chp = id & 31, jl = (chp ^ (d >> 3)) & 31;
            const v4u tv = *(const LAS v4u*)(Tl + d * 512 + chp * 16); if constexpr (!NOSTORE) *(GAS v4u*)(VS + (size_t)item * 131072 + d * 512 + jl * 8) = tv; else if (tv.x == 0x12345678u && tv.y == 0x9abcdef0u) *(GAS v4u*)(VS + (size_t)item * 131072 + d * 512 + jl * 8) = tv; }
        LDS_WAIT(); __syncthreads();
#pragma unroll 2
        for (int step = 0; step < 8; ++step) {
            const int j = step * 32 + trow; const size_t t = (size_t)c * 256 + j;
            bf16* qp = RQ + t * 2048 + h * 256 + d0;
            float lo[8], hi[8], cs[8], sn[8];
            unpack8(*(const GAS v4u*)qp, lo); unpack8(*(const GAS v4u*)(qp + 128), hi);
            { const f32x4 c0 = *(const GAS f32x4*)(COS + t * 128 + d0), c1 = *(const GAS f32x4*)(COS + t * 128 + d0 + 4), s0 = *(const GAS f32x4*)(SIN + t * 128 + d0), s1 = *(const GAS f32x4*)(SIN + t * 128 + d0 + 4);
              cs[0] = c0.x; cs[1] = c0.y; cs[2] = c0.z; cs[3] = c0.w; cs[4] = c1.x; cs[5] = c1.y; cs[6] = c1.z; cs[7] = c1.w;
              sn[0] = s0.x; sn[1] = s0.y; sn[2] = s0.z; sn[3] = s0.w; sn[4] = s1.x; sn[5] = s1.y; sn[6] = s1.z; sn[7] = s1.w; }
            float nl[8], nh[8];
#pragma unroll
            for (int i = 0; i < 8; ++i) { nl[i] = lo[i] * cs[i] - hi[i] * sn[i]; nh[i] = lo[i] * sn[i] + hi[i] * cs[i]; }
            if constexpr (!NOSTORE) { *(GAS v4u*)qp = pack8(nl); *(GAS v4u*)(qp + 128) = pack8(nh); }
            const float dec = __builtin_amdgcn_exp2f((float)(j + 1) * lg);
#pragma unroll
            for (int i = 0; i < 8; ++i) { nl[i] *= dec; nh[i] *= dec; }
            bf16* pq = PQ + (size_t)item * 131072 + (size_t)j * 512 + 256 + d0;
            if constexpr (!NOSTORE) { *(GAS v4u*)pq = pack8(nl); *(GAS v4u*)(pq + 128) = pack8(nh); } else if (nl[0] == 1.2345e30f) { *(GAS v4u*)pq = pack8(nl); *(GAS v4u*)(pq + 128) = pack8(nh); }
        }
    }
    { const bf16* MK = (const bf16*)(ws + WS_PROJ) + PROJ_STRIDE; float* KM = (float*)(ws + TAB_KMEAN);
      const int ll = F.lane & 15, rg = F.lane >> 4;
      for (int it = F.gw; it < 512; it += F.NGW) { const int j = it >> 4, h = it & 15;
          float acc[8] = {0.f, 0.f, 0.f, 0.f, 0.f, 0.f, 0.f, 0.f};
#pragma unroll 8
          for (int i = 0; i < 64; ++i) { const int r = rg + 4 * i; float f[8]; unpack8(*(const GAS v4u*)(MK + (size_t)(j * 256 + r) * 2048 + h * 128 + ll * 8), f);
#pragma unroll
              for (int e = 0; e < 8; ++e) acc[e] += f[e]; }
#pragma unroll
          for (int e = 0; e < 8; ++e) { acc[e] += __shfl_xor(acc[e], 16); acc[e] += __shfl_xor(acc[e], 32); }
          if (rg == 0) { GAS f32x4* o = (GAS f32x4*)(KM + (size_t)(j * 16 + h) * 128 + ll * 8);
              o[0] = (f32x4){acc[0], acc[1], acc[2], acc[3]} * (1.f / 256.f); o[1] = (f32x4){acc[4], acc[5], acc[6], acc[7]} * (1.f / 256.f); } } }
}

template <bool NOSTORE> __device__ __forceinline__ void p3_gating(Frame& F, unsigned char* ws) {
    const bf16* MQ = (const bf16*)(ws + WS_PROJ); const float* KM = (const float*)(ws + TAB_KMEAN);
    unsigned* CNT = (unsigned*)(ws + WS_CTL) + CW_CNT; unsigned* LIST = (unsigned*)(ws + WS_LIST);
    LAS float* kml = (LAS float*)F.lds;
    for (int item = blockIdx.x; item < 256; item += F.G) {
        const int h = item >> 4, grp = item & 15;
        __syncthreads();
        for (int i = F.tid; i < 32 * 32; i += 512) { const int j = i >> 5, c4 = i & 31; *(LAS f32x4*)(kml + j * 128 + c4 * 4) = *(const GAS f32x4*)(KM + (size_t)(j * 16 + h) * 128 + c4 * 4); }
        LDS_WAIT(); __syncthreads();
        const int q = grp * 512 + F.wave * 64 + F.lane, cur = (grp * 512 + F.wave * 64) >> 8;
        float qv[128];
#pragma unroll
        for (int k = 0; k < 16; ++k) { float f[8]; unpack8(*(const GAS v4u*)(MQ + (size_t)q * 2048 + h * 128 + k * 8), f);
#pragma unroll
            for (int e = 0; e < 8; ++e) qv[k * 8 + e] = f[e]; }
        float v1 = -__builtin_inff(), v2 = v1, v3 = v1; int i1 = 0, i2 = 0, i3 = 0;
        for (int j = 0; j < cur; ++j) { float g0 = 0.f, g1 = 0.f;
#pragma unroll
            for (int k = 0; k < 32; ++k) { const f32x4 kk = *(const LAS f32x4*)(kml + j * 128 + k * 4); g0 += qv[4 * k] * kk.x; g1 += qv[4 * k + 1] * kk.y; g0 += qv[4 * k + 2] * kk.z; g1 += qv[4 * k + 3] * kk.w; }
            const float g = g0 + g1;
            if (g > v1) { v3 = v2; i3 = i2; v2 = v1; i2 = i1; v1 = g; i1 = j; } else if (g > v2) { v3 = v2; i3 = i2; v2 = g; i2 = j; } else if (g > v3) { v3 = g; i3 = j; } }
        int nsel = cur < 3 ? cur : 3;
        if constexpr (NOSTORE) { if (v1 + v2 + v3 != 1.2345e30f) nsel = 0; }
        for (int s = 0; s < nsel; ++s) { const int blk = s == 0 ? i1 : (s == 1 ? i2 : i3);
            unsigned long long rem = __ballot(1);
            while (rem) { const int leader = __builtin_ctzll(rem); const int b = __builtin_amdgcn_readlane(blk, leader);
                const unsigned long long mask = __ballot(blk == b); const int n = __builtin_popcountll(mask);
                unsigned basep = 0; if (F.lane == leader) basep = atomicAdd(&CNT[h * 32 + b], (unsigned)n);
                basep = __builtin_amdgcn_readlane(basep, leader);
                if (blk == b) { const unsigned pos = basep + (unsigned)__builtin_popcountll(mask & ((1ull << F.lane) - 1ull)); LIST[(size_t)(h * 32 + b) * 8192 + pos] = (unsigned)q | ((unsigned)s << 16); }
                rem &= ~mask; } }
    }
}

__device__ __forceinline__ void p4_scan(Frame& F, unsigned char* ws) {
    if (F.tid >= 256) return;
    const float* UT = (const float*)(ws + WS_UT); bf16* VS = (bf16*)(ws + WS_VS);
    for (int idx = blockIdx.x * 256 + F.tid; idx < 65536; idx += F.G * 256) { const int h = idx >> 13, e = (idx >> 5) & 255, dch = idx & 31;
        const float lg = __builtin_log2f(1.f - __builtin_exp2f(-5.f - (float)h)); const float gC = __builtin_amdgcn_exp2f(256.f * lg);
        const GAS f32x4* up0 = (const GAS f32x4*)(UT + (size_t)h * 32 * 65536 + (size_t)e * 256 + dch * 8);
        bf16* vs0 = VS + (size_t)h * 32 * 131072 + (size_t)e * 512 + 256 + dch * 8;
        f32x4 s0 = {0.f, 0.f, 0.f, 0.f}, s1 = s0;
        f32x4 ua[8][2], ub[8][2];
#pragma unroll
        for (int k = 0; k < 8; ++k) { ua[k][0] = up0[(size_t)k * 16384]; ua[k][1] = up0[(size_t)k * 16384 + 1]; }
#pragma unroll
        for (int b = 0; b < 4; ++b) {
            if (b < 3) {
#pragma unroll
                for (int k = 0; k < 8; ++k) { const size_t c = (size_t)(8 * (b + 1) + k); if (b & 1) { ua[k][0] = up0[c * 16384]; ua[k][1] = up0[c * 16384 + 1]; } else { ub[k][0] = up0[c * 16384]; ub[k][1] = up0[c * 16384 + 1]; } } }
#pragma unroll
            for (int k = 0; k < 8; ++k) { const int c = 8 * b + k;
                v4u o; o.x = pk2(s0.x, s0.y); o.y = pk2(s0.z, s0.w); o.z = pk2(s1.x, s1.y); o.w = pk2(s1.z, s1.w);
                *(GAS v4u*)(vs0 + (size_t)c * 131072) = o;
                const f32x4 u0 = (b & 1) ? ub[k][0] : ua[k][0], u1 = (b & 1) ? ub[k][1] : ua[k][1];
                s0 = s0 * gC + u0; s1 = s1 * gC + u1; } } }
}

__device__ __forceinline__ unsigned off_b(unsigned row, unsigned ch) { return 256u * row + 16u * (ch ^ (((row & 3u) << 2) | ((row >> 2) & 3u))); }
__device__ __forceinline__ s16x4 vtr(const LAS unsigned char* p) { return __builtin_bit_cast(s16x4, __builtin_amdgcn_ds_read_tr16_b64_v4i16((LAS v4i16_t*)p)); }
__device__ __forceinline__ unsigned cvtpk(float lo, float hi) { unsigned r; asm volatile("v_cvt_pk_bf16_f32 %0, %1, %2" : "=v"(r) : "v"(lo), "v"(hi)); return r; }

struct MobaUnit { int h, kb, nrows, own; const unsigned* list; };
__device__ __forceinline__ MobaUnit moba_decode(const LAS int* pre, const unsigned* CNT, const unsigned* LIST, int NG, int u) {
    MobaUnit U;
    if (u < NG) { int lo = 0, hi = 511;
        while (lo < hi) { const int mid = (lo + hi + 1) >> 1; if (pre[mid] <= u) lo = mid; else hi = mid - 1; }
        const int p = lo, tile = u - pre[p]; const int cnt = (int)__hip_atomic_load(CNT + p, __ATOMIC_RELAXED, __HIP_MEMORY_SCOPE_AGENT);
        U.h = p >> 5; U.kb = p & 31; U.nrows = cnt - tile * 256 < 256 ? cnt - tile * 256 : 256; U.own = 0; U.list = LIST + (size_t)p * 8192 + tile * 256;
    } else { const int v = u - NG; U.h = v >> 5; U.kb = v & 31; U.nrows = 256; U.own = 1; U.list = LIST; }
    return U;
}
__device__ __forceinline__ void moba_stage(Frame& F, const bf16* MK, const bf16* MV, int h, int kb, int hf, LAS unsigned char* buf) {
#pragma unroll
    for (int n = 0; n < 4; ++n) { const int piece = F.wave + 8 * n, row = piece * 4 + (F.lane >> 4), ch = (F.lane & 15) ^ (((row & 3) << 2) | ((row >> 2) & 3));
        const size_t g = (size_t)(kb * 256 + hf * 128 + row) * 2048 + h * 128 + ch * 8;
        __builtin_amdgcn_global_load_lds((const unsigned*)(MK + g), (LAS unsigned*)(buf + piece * 1024), 16, 0, 0);
        __builtin_amdgcn_global_load_lds((const unsigned*)(MV + g), (LAS unsigned*)(buf + 32768 + piece * 1024), 16, 0, 0); }
}
__device__ __forceinline__ void moba_btab(Frame& F, const float* TB, int h, LAS float* bt) {
    if (F.tid < 384) bt[F.tid] = F.tid < 255 ? -__builtin_inff() : TB[h * 132 + (F.tid - 255)];
}

__device__ __forceinline__ void p4_moba(Frame& F, unsigned char* ws) {
    const unsigned* CNT = (const unsigned*)(ws + WS_CTL) + CW_CNT; const unsigned* LIST = (const unsigned*)(ws + WS_LIST);
    const bf16* MQ = (const bf16*)(ws + WS_PROJ); const bf16* MK = MQ + PROJ_STRIDE; const bf16* MV = MK + PROJ_STRIDE;
    bf16* PART = (bf16*)(ws + WS_PART); float* ML = (float*)(ws + WS_ML); const float* TB = (const float*)(ws + TAB_BIAS);
    LAS int* pre = (LAS int*)(F.lds + 140000);
    LAS float* btab0 = (LAS float*)(F.lds + 131072);
    const int lane = F.lane, r32 = lane & 31, hh = lane >> 5;
    __syncthreads();
    if (F.tid < 64) {
        int c8[8], s = 0;
#pragma unroll
        for (int k = 0; k < 8; ++k) { c8[k] = (int)((__hip_atomic_load(CNT + F.lane * 8 + k, __ATOMIC_RELAXED, __HIP_MEMORY_SCOPE_AGENT) + 255u) >> 8); s += c8[k]; }
        int inc = s;
#pragma unroll
        for (int o = 1; o < 64; o <<= 1) { const int t = __shfl_up(inc, o); if (F.lane >= o) inc += t; }
        int run = inc - s;
#pragma unroll
        for (int k = 0; k < 8; ++k) { pre[F.lane * 8 + k] = run; run += c8[k]; }
        if (F.lane == 63) pre[512] = run;
    }
    LDS_WAIT(); __syncthreads();
    const int NG = pre[512], NU = NG + 512;
    const int vcu = (F.G % 8 == 0) ? ((int)blockIdx.x % 8) * (F.G / 8) + (int)blockIdx.x / 8 : (int)blockIdx.x;
    if (vcu >= NU) return;
    const int nun = (NU - vcu + F.G - 1) / F.G;
    LAS int* utab = (LAS int*)(F.lds + 144000);
    if (F.tid < nun && F.tid < 32) { const MobaUnit T = moba_decode(pre, CNT, LIST, NG, vcu + F.tid * F.G);
        utab[F.tid * 5 + 0] = T.h; utab[F.tid * 5 + 1] = T.kb; utab[F.tid * 5 + 2] = T.nrows; utab[F.tid * 5 + 3] = T.own; utab[F.tid * 5 + 4] = (int)(T.list - LIST); }
    LDS_WAIT(); __syncthreads();
#define UTAB(k) MobaUnit{utab[(k) * 5 + 0], utab[(k) * 5 + 1], utab[(k) * 5 + 2], utab[(k) * 5 + 3], LIST + utab[(k) * 5 + 4]}
    unsigned kaddr[8];
#pragma unroll
    for (int s = 0; s < 8; ++s) kaddr[s] = off_b((unsigned)r32, (unsigned)(2 * s + hh));
    unsigned vaddr[4][2];
    { const unsigned blk = (lane >> 4) & 1, q4 = (lane & 15) >> 2, p = lane & 3;
#pragma unroll
      for (int c = 0; c < 4; ++c)
#pragma unroll
          for (int t = 0; t < 2; ++t) vaddr[c][t] = off_b(8u * t + 4u * hh + q4, 4u * c + 2u * blk + (p >> 1)) + 8u * (p & 1); }
    MobaUnit U = UTAB(0);
    moba_stage(F, MK, MV, U.h, U.kb, 0, F.lds);
    moba_btab(F, TB, U.h, btab0);
    const int rix = F.wave * 32 + r32;
    unsigned ent = (!U.own && rix < U.nrows) ? U.list[rix] : 8191u;
    int qpos_n = U.own ? U.kb * 256 + rix : (int)(ent & 0xffffu), slot_n = U.own ? 3 : (int)(ent >> 16);
    bf16x8 qn[8];
#pragma unroll
    for (int s = 0; s < 8; ++s) qn[s] = *(const GAS bf16x8*)(MQ + (size_t)qpos_n * 2048 + U.h * 128 + 16 * s + 8 * hh);
    MobaUnit Un = U;
    bf16x8 qf[8]; f32x16 o[4]; float m = -1e30f, l = 0.f; int qpos = 0, slot = 0; bool valid = false, far = false;
    for (int i = 0; i < nun; ++i) {
        const LAS float* btab = btab0 + (i & 1) * 384;
#pragma unroll
        for (int hf = 0; hf < 2; ++hf) {
            LAS unsigned char* buf = F.lds + hf * 65536;
            VM_WAIT(); LDS_WAIT(); __syncthreads();
            if (hf == 0) {
                valid = rix < U.nrows; qpos = qpos_n; slot = slot_n;
#pragma unroll
                for (int s = 0; s < 8; ++s) qf[s] = qn[s];
                if (i + 1 < nun) { Un = UTAB(i + 1); ent = (!Un.own && rix < Un.nrows) ? Un.list[rix] : 8191u; }
                moba_stage(F, MK, MV, U.h, U.kb, 1, F.lds + 65536);
                far = __all(qpos - (U.kb * 256 + 255) >= 113) != 0;
                m = -1e30f; l = 0.f;
#pragma unroll
                for (int c = 0; c < 4; ++c)
#pragma unroll
                    for (int r = 0; r < 16; ++r) o[c][r] = 0.f;
            } else if (i + 1 < nun) {
                qpos_n = Un.own ? Un.kb * 256 + rix : (int)(ent & 0xffffu); slot_n = Un.own ? 3 : (int)(ent >> 16);
#pragma unroll
                for (int s = 0; s < 8; ++s) qn[s] = *(const GAS bf16x8*)(MQ + (size_t)qpos_n * 2048 + Un.h * 128 + 16 * s + 8 * hh);
                moba_stage(F, MK, MV, Un.h, Un.kb, 0, F.lds);
                moba_btab(F, TB, Un.h, btab0 + ((i + 1) & 1) * 384);
            }
            const int kbase = U.kb * 256;
#pragma unroll
            for (int lc = 0; lc < 2; ++lc) {
                const int kc = 2 * hf + lc;
                if (U.own && kc > (F.wave >> 1)) continue;
                f32x16 p0, p1;
#pragma unroll
                for (int r = 0; r < 16; ++r) { p0[r] = 0.f; p1[r] = 0.f; }
                const LAS unsigned char* Kc = buf + lc * 16384;
                { bf16x8 ka[8], kb2[8];
#pragma unroll
                  for (int s = 0; s < 8; ++s) ka[s] = *(const LAS bf16x8*)(Kc + kaddr[s]);
#pragma unroll
                  for (int s = 0; s < 8; ++s) kb2[s] = *(const LAS bf16x8*)(Kc + 8192 + kaddr[s]);
#pragma unroll
                  for (int s = 0; s < 8; ++s) p0 = __builtin_amdgcn_mfma_f32_32x32x16_bf16(ka[s], qf[s], p0, 0, 0, 0);
#pragma unroll
                  for (int s = 0; s < 8; ++s) p1 = __builtin_amdgcn_mfma_f32_32x32x16_bf16(kb2[s], qf[s], p1, 0, 0, 0);
                  __builtin_amdgcn_sched_group_barrier(0x100, 8, 0);
#pragma unroll
                  for (int q = 0; q < 8; ++q) { __builtin_amdgcn_sched_group_barrier(0x008, 1, 0); __builtin_amdgcn_sched_group_barrier(0x100, 1, 0); }
                  __builtin_amdgcn_sched_group_barrier(0x008, 8, 0); }
                if (!far) {
                    asm volatile("" ::: "memory");
                    const int dq = qpos - (kbase + kc * 64 + 4 * hh) + 255;
#pragma unroll
                    for (int r = 0; r < 16; ++r) { const int cr = (r & 3) + 8 * (r >> 2); int i0 = dq - cr, i1 = i0 - 32;
                        i0 = i0 > 383 ? 383 : i0; i1 = i1 > 383 ? 383 : i1; i0 = i0 < 0 ? 0 : i0; i1 = i1 < 0 ? 0 : i1;
                        p0[r] += btab[i0]; p1[r] += btab[i1]; } }
                float pmax = p0[0];
#pragma unroll
                for (int r = 1; r < 16; ++r) pmax = fmaxf(pmax, p0[r]);
#pragma unroll
                for (int r = 0; r < 16; ++r) pmax = fmaxf(pmax, p1[r]);
                pmax = fmaxf(pmax, __shfl_xor(pmax, 32));
                if (!__all(pmax - m <= 8.f)) { const float mn = fmaxf(m, pmax); const float alpha = __builtin_amdgcn_exp2f(m - mn); m = mn; l *= alpha;
#pragma unroll
                    for (int c = 0; c < 4; ++c)
#pragma unroll
                        for (int r = 0; r < 16; ++r) o[c][r] *= alpha; }
                float ls = 0.f;
#pragma unroll
                for (int r = 0; r < 16; ++r) { p0[r] = __builtin_amdgcn_exp2f(p0[r] - m); p1[r] = __builtin_amdgcn_exp2f(p1[r] - m); ls += p0[r] + p1[r]; }
                l += ls;
                const LAS unsigned char* Vc = buf + 32768 + lc * 16384;
                { v4u pw[4];
                  pw[0].x = cvtpk(p0[0], p0[1]); pw[0].y = cvtpk(p0[2], p0[3]); pw[0].z = cvtpk(p0[4], p0[5]); pw[0].w = cvtpk(p0[6], p0[7]);
                  pw[1].x = cvtpk(p0[8], p0[9]); pw[1].y = cvtpk(p0[10], p0[11]); pw[1].z = cvtpk(p0[12], p0[13]); pw[1].w = cvtpk(p0[14], p0[15]);
                  pw[2].x = cvtpk(p1[0], p1[1]); pw[2].y = cvtpk(p1[2], p1[3]); pw[2].z = cvtpk(p1[4], p1[5]); pw[2].w = cvtpk(p1[6], p1[7]);
                  pw[3].x = cvtpk(p1[8], p1[9]); pw[3].y = cvtpk(p1[10], p1[11]); pw[3].z = cvtpk(p1[12], p1[13]); pw[3].w = cvtpk(p1[14], p1[15]);
#pragma unroll
                  for (int ss = 0; ss < 4; ++ss) {
                      const bf16x8 pb = __builtin_bit_cast(bf16x8, pw[ss]);
#pragma unroll
                      for (int c = 0; c < 4; ++c) { const s16x4 lo = vtr(Vc + ss * 4096 + vaddr[c][0]), hi = vtr(Vc + ss * 4096 + vaddr[c][1]);
                          const bf16x8 va = __builtin_shufflevector(lo, hi, 0, 1, 2, 3, 4, 5, 6, 7);
                          o[c] = __builtin_amdgcn_mfma_f32_32x32x16_bf16(va, pb, o[c], 0, 0, 0); } }
                  __builtin_amdgcn_sched_group_barrier(0x100, 8, 0);
#pragma unroll
                  for (int q = 0; q < 12; ++q) { __builtin_amdgcn_sched_group_barrier(0x008, 1, 0); __builtin_amdgcn_sched_group_barrier(0x100, 2, 0); }
                  __builtin_amdgcn_sched_group_barrier(0x008, 4, 0); }
            }
            if (hf == 1) {
                l += __shfl_xor(l, 32);
                if (far) m += btab[383];
                if (valid) {
                    const float il = 1.f / l; const size_t pbase = (((size_t)qpos * 16 + U.h) * 4 + slot);
                    bf16* po = PART + pbase * 128;
#pragma unroll
                    for (int c = 0; c < 4; ++c)
#pragma unroll
                        for (int g = 0; g < 4; ++g) { v2u w; w.x = pk2(o[c][4 * g] * il, o[c][4 * g + 1] * il); w.y = pk2(o[c][4 * g + 2] * il, o[c][4 * g + 3] * il);
                            *(GAS v2u*)(po + 32 * c + 8 * g + 4 * hh) = w; }
                    if (hh == 0) *(GAS f32x2*)(ML + pbase * 2) = (f32x2){m, l};
                }
                U = Un;
            }
        }
    }
#undef UTAB
}

__device__ __forceinline__ void p5_combine(Frame& F, unsigned char* ws) {
    const bf16* PART = (const bf16*)(ws + WS_PART); const float* ML = (const float*)(ws + WS_ML); bf16* MIX = (bf16*)(ws + WS_MIX);
    const int l16 = F.lane & 15, sub = F.lane >> 4;
    for (int pi0 = F.gw * 4 + sub; pi0 < T_ * 16; pi0 += F.NGW * 8) {
        f32x2 ml[2][4]; v4u pv[2][4]; int nv[2];
#pragma unroll
        for (int u = 0; u < 2; ++u) { const int pi = pi0 + u * F.NGW * 4; const int q = pi >> 4; nv[u] = (q >> 8) < 3 ? (q >> 8) : 3; const size_t pb = (size_t)pi * 4;
#pragma unroll
            for (int s = 0; s < 4; ++s) { const bool on = pi < T_ * 16 && ((s == 3) || (s < nv[u]));
                ml[u][s] = on ? *(const GAS f32x2*)(ML + (pb + s) * 2) : (f32x2){-1e30f, 0.f};
                pv[u][s] = on ? *(const GAS v4u*)(PART + (pb + s) * 128 + l16 * 8) : (v4u){0u, 0u, 0u, 0u}; } }
#pragma unroll
        for (int u = 0; u < 2; ++u) { const int pi = pi0 + u * F.NGW * 4; if (pi >= T_ * 16) continue; const int q = pi >> 4, h = pi & 15;
            float M = fmaxf(fmaxf(ml[u][0].x, ml[u][1].x), fmaxf(ml[u][2].x, ml[u][3].x));
            float acc[8] = {0.f, 0.f, 0.f, 0.f, 0.f, 0.f, 0.f, 0.f}; float W = 0.f;
#pragma unroll
            for (int s = 0; s < 4; ++s) { const float w = __builtin_amdgcn_exp2f(ml[u][s].x - M) * ml[u][s].y; W += w; float f[8]; unpack8(pv[u][s], f);
#pragma unroll
                for (int e = 0; e < 8; ++e) acc[e] += w * f[e]; }
            const float iw = 1.f / W;
#pragma unroll
            for (int e = 0; e < 8; ++e) acc[e] *= iw;
            *(GAS v4u*)(MIX + (size_t)q * 4096 + h * 128 + l16 * 8) = pack8(acc); } }
}

__device__ __forceinline__ unsigned f2ord(float f) { const unsigned u = __builtin_bit_cast(unsigned, f); return (u & 0x80000000u) ? ~u : (u | 0x80000000u); }
__device__ __forceinline__ float ord2f(unsigned o) { return __builtin_bit_cast(float, (o & 0x80000000u) ? (o ^ 0x80000000u) : ~o); }
#define CEX(a, b) do { const unsigned _hi = (a) > (b) ? (a) : (b); const unsigned _lo = (a) > (b) ? (b) : (a); (a) = _hi; (b) = _lo; } while (0)
__device__ __forceinline__ void bitonic_merge16(unsigned (&a)[16]) {
#pragma unroll
    for (int j = 8; j > 0; j >>= 1)
#pragma unroll
        for (int i = 0; i < 16; ++i) if ((i & j) == 0) CEX(a[i], a[i | j]);
}
__device__ __forceinline__ void sort16_desc(unsigned (&a)[16]) {
#pragma unroll
    for (int k = 2; k <= 16; k <<= 1)
#pragma unroll
        for (int j = k >> 1; j > 0; j >>= 1)
#pragma unroll
            for (int i = 0; i < 16; ++i) { const int l = i ^ j; if (l > i) { if ((i & k) == 0 || k == 16) { CEX(a[i], a[l]); } else { CEX(a[l], a[i]); } } }
}
__device__ __forceinline__ void merge_top16(unsigned (&L)[16], const unsigned (&G)[16]) {
#pragma unroll
    for (int i = 0; i < 16; ++i) L[i] = L[i] > G[15 - i] ? L[i] : G[15 - i];
    bitonic_merge16(L);
}

template <int MODE> __device__ __forceinline__ void p9_peer_route(Frame& F, unsigned char* ws) {
    const bf16* PQP = (const bf16*)(ws + WS_PQP); const bf16* KEYS = (const bf16*)(ws + TAB_KEYS); bf16* GW = (bf16*)(ws + WS_GW); unsigned* BM = (unsigned*)(ws + WS_BM);
    LAS unsigned* LE = (LAS unsigned*)F.lds; LAS float* LG = (LAS float*)(F.lds + 8192);
    LAS unsigned* HVAL = (LAS unsigned*)(F.lds + 16384);
    LAS unsigned* HKEY = (LAS unsigned*)(F.lds + 81920);
    LAS unsigned* BMl = (LAS unsigned*)(F.lds + 98304);
    LAS unsigned* ABL = (LAS unsigned*)(F.lds + 102400);
    const int lane = F.lane, w = F.wave, tk = lane & 15, q = lane >> 4;
    for (int unit = blockIdx.x; unit < T_ / 16; unit += F.G) {
        const int t0 = unit * 16;
        __syncthreads();
        { const v4u z = {0u, 0u, 0u, 0u}, ff = {0xffffffffu, 0xffffffffu, 0xffffffffu, 0xffffffffu};
          for (int i = F.tid; i < 65536 / 16; i += 512) *(LAS v4u*)((LAS unsigned char*)HVAL + i * 16) = z;
          for (int i = F.tid; i < 16384 / 16; i += 512) *(LAS v4u*)((LAS unsigned char*)HKEY + i * 16) = ff;
          if (F.tid < 256) *(LAS v4u*)((LAS unsigned char*)BMl + F.tid * 16) = z; }
        unsigned AB[2][16];
#pragma unroll
        for (int c = 0; c < 2; ++c) {
            bf16x8 af[4];
#pragma unroll
            for (int ks = 0; ks < 4; ++ks) af[ks] = *(const GAS bf16x8*)(PQP + (size_t)(t0 + tk) * 2048 + w * 256 + c * 128 + 32 * ks + 8 * q);
            unsigned kk[2][16];
#pragma unroll
            for (int nt = 0; nt < 8; ++nt) { f32x4 acc = {0.f, 0.f, 0.f, 0.f};
#pragma unroll
                for (int ks = 0; ks < 4; ++ks) { const bf16x8 kf = *(const GAS bf16x8*)(KEYS + (size_t)((w * 2 + c) * 128 + 16 * nt + tk) * 128 + 32 * ks + 8 * q);
                    acc = __builtin_amdgcn_mfma_f32_16x16x32_bf16(kf, af[ks], acc, 0, 0, 0); }
#pragma unroll
                for (int r = 0; r < 4; ++r) kk[nt >> 2][(nt & 3) * 4 + r] = (f2ord(acc[r]) & 0xffffff80u) | (unsigned)(16 * nt + 4 * q + r); }
            sort16_desc(kk[0]); sort16_desc(kk[1]); merge_top16(kk[0], kk[1]);
            unsigned G[16];
#pragma unroll
            for (int i = 0; i < 16; ++i) G[i] = (unsigned)__shfl_xor((int)kk[0][i], 16);
            merge_top16(kk[0], G);
#pragma unroll
            for (int i = 0; i < 16; ++i) G[i] = (unsigned)__shfl_xor((int)kk[0][i], 32);
            merge_top16(kk[0], G);
#pragma unroll
            for (int i = 0; i < 16; ++i) AB[c][i] = kk[0][i];
        }
        if (q == 0) {
#pragma unroll
            for (int i = 0; i < 4; ++i) { *(LAS v4u*)(ABL + (w * 16 + tk) * 32 + 4 * i) = (v4u){AB[0][4 * i], AB[0][4 * i + 1], AB[0][4 * i + 2], AB[0][4 * i + 3]};
                *(LAS v4u*)(ABL + (w * 16 + tk) * 32 + 16 + 4 * i) = (v4u){AB[1][4 * i], AB[1][4 * i + 1], AB[1][4 * i + 2], AB[1][4 * i + 3]}; } }
        if constexpr (MODE != 3) {
        unsigned M[16];
#pragma unroll
        for (int i = 0; i < 16; ++i) M[i] = 0u;
        { float av[16], bv[16];
#pragma unroll
          for (int i = 0; i < 16; ++i) { av[i] = ord2f(AB[0][i] & 0xffffff80u); bv[i] = ord2f(AB[1][i] & 0xffffff80u); }
          unsigned cd[16]; int nc = 0;
#pragma unroll
          for (int i = 0; i < 16; ++i)
#pragma unroll
              for (int j = 0; j < 16; ++j) if ((i + 1) * (j + 1) <= 16) {
                  cd[nc & 15] = (f2ord(av[i] + bv[j]) & 0xffffff00u) | (unsigned)(i * 16 + j); ++nc;
                  if ((nc & 15) == 0) { sort16_desc(cd); if (nc == 16) {
#pragma unroll
                      for (int x = 0; x < 16; ++x) M[x] = cd[x]; } else merge_top16(M, cd); } }
#pragma unroll
          for (int x = 2; x < 16; ++x) cd[x] = 0u;
          sort16_desc(cd); merge_top16(M, cd); }
        LDS_WAIT(); __builtin_amdgcn_wave_barrier();
        { float sc[16]; float mx = -__builtin_inff();
#pragma unroll
          for (int k = 0; k < 16; ++k) { sc[k] = ord2f(M[k] & 0xffffff00u); mx = fmaxf(mx, sc[k]); }
          float sum = 0.f;
#pragma unroll
          for (int k = 0; k < 16; ++k) { sc[k] = __builtin_amdgcn_exp2f((sc[k] - mx) * LOG2E); sum += sc[k]; }
          const float is = 1.f / sum;
#pragma unroll
          for (int k = 0; k < 16; ++k) if ((k >> 2) == q) { const unsigned id = M[k] & 255u, i = id >> 4, j = id & 15u;
              const unsigned ea = ABL[(w * 16 + tk) * 32 + i] & 127u, eb = ABL[(w * 16 + tk) * 32 + 16 + j] & 127u;
              LE[tk * 128 + w * 16 + k] = ea * 128u + eb; LG[tk * 128 + w * 16 + k] = sc[k] * is; } }
        } else { if (AB[0][0] == 0x12345u && AB[1][5] == 7u) LE[tk] = AB[0][3]; }
        LDS_WAIT(); __syncthreads();
        if constexpr (MODE <= 1) {
#pragma unroll
        for (int k = 0; k < 4; ++k) { const int pidx = F.tid + 512 * k, tok = pidx >> 7; const unsigned e = LE[pidx]; const float g = LG[pidx]; const unsigned ch = e >> 3;
            unsigned hs = (ch * 0x9E3779B1u) >> 24;
            for (;;) { unsigned expect = 0xffffffffu;
                const bool ok = __hip_atomic_compare_exchange_strong(HKEY + tok * 256 + hs, &expect, ch, __ATOMIC_RELAXED, __ATOMIC_RELAXED, __HIP_MEMORY_SCOPE_WORKGROUP);
                if (ok || expect == ch) break; hs = (hs + 1u) & 255u; }
            const unsigned gb = f2bf(g);
            __builtin_amdgcn_ds_atomic_fadd_v2bf16((LAS s16x2*)(HVAL + ((tok * 256 + hs) * 4 + ((e & 7u) >> 1))), __builtin_bit_cast(s16x2, (e & 1u) ? (gb << 16) : gb)); }
        LDS_WAIT(); __syncthreads();
#pragma unroll
        for (int k = 0; k < 8; ++k) { const int sidx = F.tid + 512 * k, tok = sidx >> 8; const unsigned ch = HKEY[sidx];
            if (ch != 0xffffffffu) {
                if constexpr (MODE == 0) *(GAS v4u*)(GW + (size_t)(t0 + tok) * 16384 + ch * 8) = *(const LAS v4u*)(HVAL + sidx * 4);
                __hip_atomic_fetch_or(BMl + tok * 64 + (ch >> 5), 1u << (ch & 31u), __ATOMIC_RELAXED, __HIP_MEMORY_SCOPE_WORKGROUP); } }
        LDS_WAIT(); __syncthreads();
        }
        if constexpr (MODE == 0)
        for (int i = F.tid; i < 1024; i += 512) BM[(size_t)t0 * 64 + i] = BMl[i];
    }
}

__device__ __forceinline__ void p12_final_norm(Frame& F, const Args& args) {
    for (int m = F.gw; m < T_; m += F.NGW) { float* row = args.out + (size_t)m * DM; const GAS f32x4* xr = (const GAS f32x4*)row + F.lane; const GAS f32x4* gr = (const GAS f32x4*)args.in[10] + F.lane;
        f32x4 v[16]; float s = 0.f;
#pragma unroll
        for (int j = 0; j < 16; ++j) { v[j] = xr[64 * j]; s += (v[j].x * v[j].x + v[j].y * v[j].y) + (v[j].z * v[j].z + v[j].w * v[j].w); }
        const float rstd = 1.f / sqrtf(wave_sum(s) * (1.f / DM) + NORM_EPS);
        GAS f32x4* o = (GAS f32x4*)row + F.lane;
#pragma unroll
        for (int j = 0; j < 16; ++j) o[64 * j] = v[j] * rstd * gr[64 * j]; }
}

constexpr int NPH = 13;
__global__ void __launch_bounds__(512, 2) fwd(Args args) {
    extern __shared__ __attribute__((aligned(16))) unsigned char lds_raw[];
    Frame F;
    F.lds = (LAS unsigned char*)lds_raw;
    F.tid = threadIdx.x; F.lane = F.tid & 63; F.wave = __builtin_amdgcn_readfirstlane(F.tid >> 6);
    F.G = gridDim.x; F.gw = blockIdx.x * 8 + F.wave; F.NGW = F.G * 8;
    unsigned char* ws = args.ws;
    volatile LAS unsigned* MISC = (volatile LAS unsigned*)(F.lds + MISC_OFF);
    for (int u = F.tid; u < (LDS_BYTES - LDSCTL_OFF) / 4; u += 512) ((LAS unsigned*)(F.lds + LDSCTL_OFF))[u] = 0u;
    __syncthreads();
    XcdBarrier bar = xcd_barrier_post((unsigned*)(ws + WS_CTL) + CW_BAR, MISC + 8);
    const int lo = args.ph_lo, hi = args.ph_hi;
#ifndef PHMASK
#define PHMASK 0xffff
#endif
#define IN(k) (((PHMASK >> (k)) & 1) && lo <= (k) && (k) < hi)
#define SEAM(k) do { if (IN(k) && IN((k) + 1)) xcd_barrier(bar); } while (0)
#ifndef PHDUP
#define PHDUP 0
#endif
#define DUPQ(k) (((PHDUP >> (k)) & 1) != 0)
    bf16* XN = (bf16*)(ws + WS_XN); bf16* MIX = (bf16*)(ws + WS_MIX); float* H1 = (float*)(ws + WS_H1);

#define PHASE(k, ...) if (IN(k)) { { __VA_ARGS__ } if (DUPQ(k)) { xcd_barrier(bar); { __VA_ARGS__ } } } SEAM(k);
    PHASE(0, p0_prologue(F, args);)
    PHASE(1,
        { pg8::Gemm g{(const bf16*)(ws + WS_XN8), (const bf16*)(ws + WS_WIN8), DM / 2, DM / 2, DM / 2, 0, 0}; pg8::StaticOrder S; S.init(T_, 3 * MW, F.G, (int)blockIdx.x);
          pg8::EpiBf16<0> E{(bf16*)(ws + WS_PROJ), 2048, nullptr, 2048, PROJ_STRIDE, QSCALE, 1.f / (XN8_SCALE * WIN8_SCALE)};
          pg8::gemm_phase<pg8::EpiBf16<0>, pg8::StaticOrder, true, true, 1>(F.lds, g, S, E); }
        { pg8::Gemm g{XN, (const bf16*)(ws + WS_WINB), DM, DM, DM, 0, 0}; pg8::StaticOrder S; S.init(T_, INW - 3 * MW, F.G, (int)blockIdx.x);
          pg8::EpiBf16<0> E{(bf16*)(ws + WS_PROJ) + 3 * PROJ_STRIDE, 2048, nullptr, 2048, PROJ_STRIDE, 1.f, 1.f};
          pg8::gemm_phase<pg8::EpiBf16<0>, pg8::StaticOrder, true, true>(F.lds, g, S, E); })
    if (IN(2)) { p2_prep<false>(F, ws); if (DUPQ(2)) { xcd_barrier(bar); p2_prep<true>(F, ws); } } SEAM(2);
#ifndef P3SUB
#define P3SUB 7
#endif
#define P3_PGEMM { pg8::Gemm g{(const bf16*)(ws + WS_PROJ) + 3 * PROJ_STRIDE, (const bf16*)(ws + WS_PROJ) + 4 * PROJ_STRIDE, 2048, 2048, 256, 256, 256}; \
          pg8::HOrder S{F.G, (int)blockIdx.x}; pg8::EpiRetP E{(bf16*)(ws + WS_PQ)}; \
          pg8::gemm_phase<pg8::EpiRetP, pg8::HOrder, false, true>(F.lds, g, S, E); }
#define P3_UTGEMM { pg8::Gemm g{(const bf16*)(ws + WS_VS), (const bf16*)(ws + WS_KT), 512, 256, 256, 131072, 65536}; pg8::BatchOrder S{256, F.G, (int)blockIdx.x}; \
          pg8::EpiF32Z E{(float*)(ws + WS_UT)}; \
          pg8::gemm_phase<pg8::EpiF32Z, pg8::BatchOrder, false, true>(F.lds, g, S, E); }
    if (IN(3)) {
        P3_PGEMM P3_UTGEMM p3_gating<false>(F, ws);
        if (DUPQ(3)) { xcd_barrier(bar); if (P3SUB & 1) P3_PGEMM if (P3SUB & 2) P3_UTGEMM if (P3SUB & 4) p3_gating<true>(F, ws); }
    } SEAM(3);
#ifndef P4SUB
#define P4SUB 3
#endif
    if (IN(4)) { p4_scan(F, ws); p4_moba(F, ws); if (DUPQ(4)) { xcd_barrier(bar); if (P4SUB & 1) p4_scan(F, ws); if (P4SUB & 2) p4_moba(F, ws); } } SEAM(4);
    PHASE(5,
        { pg8::Gemm g{(const bf16*)(ws + WS_PQ), (const bf16*)(ws + WS_VS), 512, 512, 512, 131072, 131072}; pg8::EpiRetOut E{(const bf16*)(ws + WS_PROJ) + 6 * PROJ_STRIDE, MIX};
          pg8::OneOrder O{(int)blockIdx.x};
          pg8::gemm_phase<pg8::EpiRetOut, pg8::OneOrder, false, true>(F.lds, g, O, E); __syncthreads(); }
        p5_combine(F, ws);)
    PHASE(6,
        pg8::Gemm g{MIX, (const bf16*)(ws + WS_WOUT_T), DM, DM, DM, 0, 0}; pg8::StaticOrder S; S.init(T_, DM, F.G, (int)blockIdx.x);
        pg8::EpiResF32 E{args.in[0], H1, DM, 1.f};
        pg8::gemm_phase<pg8::EpiResF32, pg8::StaticOrder, true, true>(F.lds, g, S, E);)
    PHASE(7, for (int m = F.gw; m < T_; m += F.NGW) rms_row_to_bf16<1>(F.lane, H1 + (size_t)m * DM, args.in[5], XN + (size_t)m * DM, ws + WS_TN8 + (size_t)m * DM);)
    PHASE(8,
        pg8::Gemm g{XN, (const bf16*)(ws + WS_WQ_T), DM, DM, DM, 0, 0}; pg8::StaticOrder S; S.init(T_, 2048, F.G, (int)blockIdx.x);
        pg8::EpiBf16<0> E{(bf16*)(ws + WS_PQP), 2048, nullptr, 0, 0, 1.f, 1.f};
        pg8::gemm_phase<pg8::EpiBf16<0>, pg8::StaticOrder, true, true>(F.lds, g, S, E);)
#ifndef P9MODE
#define P9MODE 0
#endif
    if (IN(9)) { p9_peer_route<0>(F, ws); if (DUPQ(9)) { xcd_barrier(bar); p9_peer_route<(P9MODE ? P9MODE : 1)>(F, ws); } } SEAM(9);
#ifndef P10MODE
#define P10MODE 1
#endif
    if (IN(10)) {
        { pg8::Gemm g{(const bf16*)(ws + WS_TN8), (const bf16*)(ws + WS_U8), DM / 2, DM / 2, DM / 2, 0, 0}; pg8::StaticOrder S; S.init(T_, NEXP, F.G, (int)blockIdx.x);
          pg8::EpiPeerW8<0> E{(const bf16*)(ws + WS_GW), (const unsigned*)(ws + WS_BM), ws + WS_W8, 1.f / (TN8_SCALE * U8_SCALE), W8_SCALE};
          pg8::gemm_phase<pg8::EpiPeerW8<0>, pg8::StaticOrder, true, true, 1>(F.lds, g, S, E); }
        if (DUPQ(10)) { xcd_barrier(bar);
          pg8::Gemm g{(const bf16*)(ws + WS_TN8), (const bf16*)(ws + WS_U8), DM / 2, DM / 2, DM / 2, 0, 0}; pg8::StaticOrder S; S.init(T_, NEXP, F.G, (int)blockIdx.x);
          pg8::EpiPeerW8<P10MODE> E{(const bf16*)(ws + WS_GW), (const unsigned*)(ws + WS_BM), ws + WS_GW, 1.f / (TN8_SCALE * U8_SCALE), W8_SCALE};
          pg8::gemm_phase<pg8::EpiPeerW8<P10MODE>, pg8::StaticOrder, true, true, 1>(F.lds, g, S, E); }
    } SEAM(10);
    PHASE(11,
        pg8::Gemm g{(const bf16*)(ws + WS_W8), (const bf16*)(ws + WS_V8T), NEXP / 2, NEXP / 2, NEXP / 2, 0, 0}; pg8::StaticOrder S; S.init(T_, DM, F.G, (int)blockIdx.x);
        pg8::EpiResF32 E{H1, args.out, DM, 1.f / (W8_SCALE * V8_SCALE)};
        pg8::gemm_phase<pg8::EpiResF32, pg8::StaticOrder, true, true, 1>(F.lds, g, S, E);)
#ifdef F6PROBE
    if (IN(11)) { xcd_barrier(bar);
        { pg8::Gemm g{(const bf16*)(ws + WS_W8), (const bf16*)(ws + WS_V8T), NEXP / 2, NEXP / 2, NEXP / 2, 0, 0}; pg8::StaticOrder S; S.init(T_, DM, F.G, (int)blockIdx.x);
          pg8::EpiResF32 E{H1, (float*)(ws + WS_GW), DM, 1.f};
          pg8::gemm_phase<pg8::EpiResF32, pg8::StaticOrder, true, true, 2>(F.lds, g, S, E); }
        xcd_barrier(bar); }
#endif
    if (IN(12)) p12_final_norm(F, args);
#undef PHASE
#undef IN
#undef SEAM
}

extern "C" void kernel_launch(void* const* d_in, const int* in_sizes, int n_in, void* d_out, int out_size, void* d_ws, size_t ws_size, hipStream_t stream) {
    static int grid = 0;
    if (grid == 0) {
        if (n_in != 11 || ws_size < WS_END) { fprintf(stderr, "kernel_launch: built for 11 inputs and >= %zu bytes of workspace; got n_in %d, ws %zu\n", (size_t)WS_END, n_in, ws_size); grid = -1; return; }
        int dev = 0, cus = 0, per_cu = 0;
        if (hipGetDevice(&dev) != hipSuccess || hipDeviceGetAttribute(&cus, hipDeviceAttributeMultiprocessorCount, dev) != hipSuccess) { grid = -1; return; }
        if (hipFuncSetAttribute((const void*)fwd, hipFuncAttributeMaxDynamicSharedMemorySize, LDS_BYTES) != hipSuccess) { fprintf(stderr, "kernel_launch: hipFuncSetAttribute failed\n"); grid = -1; return; }
        if (hipOccupancyMaxActiveBlocksPerMultiprocessor(&per_cu, (const void*)fwd, 512, LDS_BYTES) != hipSuccess || per_cu < 1) fprintf(stderr, "kernel_launch: occupancy query reports %d\n", per_cu);
        (void)hipGetLastError();
        grid = cus;
    }
    if (grid < 0) return;
    if (hipMemsetAsync((char*)d_ws + WS_CTL, 0, CTL_ZERO_BYTES, stream) != hipSuccess) return;
    Args a{};
    for (int i = 0; i < 11; ++i) a.in[i] = (const float*)d_in[i];
    a.out = (float*)d_out; a.ws = (unsigned char*)d_ws;
#if MK_ONE_LAUNCH
    a.ph_lo = 0; a.ph_hi = NPH;
    hipLaunchKernelGGL(fwd, dim3(grid), dim3(512), LDS_BYTES, stream, a);
#else
    for (int p = 0; p < NPH; ++p) { a.ph_lo = p; a.ph_hi = p + 1; hipLaunchKernelGGL(fwd, dim3(grid), dim3(512), LDS_BYTES, stream, a); }
#endif
}
```
